# Optimizing an MI355X kernel written in HIP

```python
import jax, jax.numpy as jnp
from jax import lax
import numpy as np

D_MODEL = 1024
BATCH = 8
SEQ = 4096
DEPTH = 1

MEM_LEN = 256
MIX_WIDTH = D_MODEL
A_WIDTH = MIX_WIDTH // 2
B_WIDTH = MIX_WIDTH - A_WIDTH
A_HEADS = 4
A_HEAD_DIM = A_WIDTH // A_HEADS
B_HEADS = 4
CHUNK = 128
CONV_W = 3
IN_A = 2 * A_WIDTH
IN_B = 3 * B_WIDTH
IN_TOTAL = IN_A + IN_B
X_HEADS = 4
X_HEAD_DIM = D_MODEL // X_HEADS
D_FF = ((8 * D_MODEL // 3 + 255) // 256) * 256
EPS = 1e-6

kernel_name = "hybrid_sgu_shortconv_xattn_layer"


def rms_norm(x, g):
    xf = x.astype(jnp.float32)
    y = xf * lax.rsqrt(jnp.mean(xf * xf, axis=-1, keepdims=True) + EPS)
    return (y * g.astype(jnp.float32)).astype(x.dtype)


def layer_norm(x, g, b):
    xf = x.astype(jnp.float32)
    mu = jnp.mean(xf, axis=-1, keepdims=True)
    var = jnp.mean(jnp.square(xf - mu), axis=-1, keepdims=True)
    y = (xf - mu) * lax.rsqrt(var + EPS)
    return (y * g.astype(jnp.float32) + b.astype(jnp.float32)).astype(x.dtype)


def spatial_gating(a, sgu_ln_g, sgu_ln_b, w_spatial, b_spatial):
    bsz, seq, _ = a.shape
    a = jax.nn.gelu(a)
    u, v = jnp.split(a, 2, axis=-1)
    v = layer_norm(v, sgu_ln_g, sgu_ln_b)
    n_chunks = seq // CHUNK
    v = v.reshape(bsz, n_chunks, CHUNK, A_HEADS, A_HEAD_DIM)
    mask = jnp.tril(jnp.ones((CHUNK, CHUNK), dtype=w_spatial.dtype))
    w = w_spatial * mask[None]
    mixed = jnp.einsum("hts,bnshd->bnthd", w, v)
    mixed = mixed + jnp.transpose(b_spatial)[None, None, :, :, None]
    mixed = mixed.reshape(bsz, seq, A_WIDTH)
    return u * mixed


def short_gated_conv(h, conv_w):
    gate_b, gate_c, val = jnp.split(h, 3, axis=-1)
    z = gate_c * val
    zp = jnp.pad(z, ((0, 0), (CONV_W - 1, 0), (0, 0)))
    seq = z.shape[1]
    conv = (conv_w[0] * zp[:, 0:seq] + conv_w[1] * zp[:, 1:seq + 1]
            + conv_w[2] * zp[:, 2:seq + 2])
    return gate_b * conv


def cross_attention(h, memn, w_q, w_kv, w_o):
    bsz, seq, _ = h.shape
    q = (h @ w_q).reshape(bsz, seq, X_HEADS, X_HEAD_DIM)
    k, v = jnp.split(memn @ w_kv, 2, axis=-1)
    k = k.reshape(bsz, MEM_LEN, X_HEADS, X_HEAD_DIM)
    v = v.reshape(bsz, MEM_LEN, X_HEADS, X_HEAD_DIM)
    scale = X_HEAD_DIM ** -0.5
    s = jnp.einsum("bshd,bmhd->bhsm", q, k).astype(jnp.float32) * scale
    p = jax.nn.softmax(s, axis=-1).astype(v.dtype)
    o = jnp.einsum("bhsm,bmhd->bshd", p, v).reshape(bsz, seq, D_MODEL)
    return o @ w_o


def setup_inputs(seed: int = 0) -> dict:
    key = jax.random.key(seed)
    ks = jax.random.split(key, 24)
    f32 = jnp.float32
    nrm = lambda k, shape, scale: jax.random.normal(k, shape, f32) * scale
    gain = lambda k, n: 1.0 + 0.02 * jax.random.normal(k, (n,), f32)
    return {
        "x": jax.random.normal(ks[0], (BATCH, SEQ, D_MODEL), f32),
        "mem": jax.random.normal(ks[1], (BATCH, MEM_LEN, D_MODEL), f32),
        "ln_mix_g": gain(ks[2], D_MODEL),
        "w_in": nrm(ks[3], (D_MODEL, IN_TOTAL), D_MODEL ** -0.5),
        "sgu_ln_g": gain(ks[4], A_WIDTH),
        "sgu_ln_b": nrm(ks[5], (A_WIDTH,), 0.02),
        "w_spatial": nrm(ks[6], (A_HEADS, CHUNK, CHUNK), CHUNK ** -0.5),
        "b_spatial": 1.0 + nrm(ks[7], (A_HEADS, CHUNK), 0.02),
        "conv_w": nrm(ks[8], (CONV_W, B_WIDTH), CONV_W ** -0.5),
        "grp_norm_a": gain(ks[9], A_WIDTH),
        "grp_norm_b": gain(ks[10], B_WIDTH),
        "w_out": nrm(ks[11], (MIX_WIDTH, D_MODEL), MIX_WIDTH ** -0.5),
        "ln_attn_g": gain(ks[12], D_MODEL),
        "ln_mem_g": gain(ks[13], D_MODEL),
        "w_q": nrm(ks[14], (D_MODEL, D_MODEL), D_MODEL ** -0.5),
        "w_kv": nrm(ks[15], (D_MODEL, 2 * D_MODEL), D_MODEL ** -0.5),
        "w_o": nrm(ks[16], (D_MODEL, D_MODEL), D_MODEL ** -0.5),
        "ln_ffn_g": gain(ks[17], D_MODEL),
        "w_gate_up": nrm(ks[18], (D_MODEL, 2 * D_FF), D_MODEL ** -0.5),
        "w_down": nrm(ks[19], (D_FF, D_MODEL), D_FF ** -0.5),
        "ln_final_g": gain(ks[20], D_MODEL),
    }


def reference(x, mem, ln_mix_g, w_in, sgu_ln_g, sgu_ln_b, w_spatial, b_spatial,
              conv_w, grp_norm_a, grp_norm_b, w_out, ln_attn_g, ln_mem_g,
              w_q, w_kv, w_o, ln_ffn_g, w_gate_up, w_down, ln_final_g):
    memn = rms_norm(mem, ln_mem_g)
    for _ in range(DEPTH):
        h = rms_norm(x, ln_mix_g) @ w_in
        h_a = h[..., :IN_A]
        h_b = h[..., IN_A:]
        y_a = rms_norm(spatial_gating(h_a, sgu_ln_g, sgu_ln_b, w_spatial, b_spatial), grp_norm_a)
        y_b = rms_norm(short_gated_conv(h_b, conv_w), grp_norm_b)
        x = x + jnp.concatenate([y_a, y_b], axis=-1) @ w_out
        x = x + cross_attention(rms_norm(x, ln_attn_g), memn, w_q, w_kv, w_o)
        g, u = jnp.split(rms_norm(x, ln_ffn_g) @ w_gate_up, 2, axis=-1)
        x = x + (jax.nn.silu(g) * u) @ w_down
    return rms_norm(x, ln_final_g)
```

```cpp
#include <hip/hip_runtime.h>
#include <hip/hip_cooperative_groups.h>
#include <cstdio>
#include <cstdint>
namespace cg = cooperative_groups;

#ifndef MK_PROBE
#define MK_PROBE 0
#endif
#ifndef MK_MODE
#define MK_MODE 2
#endif

constexpr int D = 1024, BATCH = 8, SEQ = 4096, M = BATCH * SEQ;
constexpr int MEML = 256, MROWS = BATCH * MEML;
constexpr int NIN = 2560, DFF = 2816, NGU = 2 * DFF;
constexpr int CHUNK = 128, NCHUNK = M / CHUNK;
constexpr float EPS = 1e-6f;
constexpr float QSCALE = 0.0625f * 1.4426950408889634f;

typedef unsigned short bf16_t;
typedef short bf16x8 __attribute__((ext_vector_type(8)));
typedef float f32x4 __attribute__((ext_vector_type(4)));
typedef float f32x2 __attribute__((ext_vector_type(2)));
typedef unsigned u32x4 __attribute__((ext_vector_type(4)));
typedef unsigned u32x2 __attribute__((ext_vector_type(2)));
typedef short s16x4 __attribute__((ext_vector_type(4)));
#define LAS __attribute__((address_space(3)))

constexpr size_t MiB = 1u << 20;
constexpr size_t WS_CTL = 0;
constexpr size_t WS_WIN = 2 * MiB, WS_WOUT = 7 * MiB, WS_WQ = 9 * MiB, WS_WKV = 11 * MiB, WS_WO = 15 * MiB, WS_WGU = 17 * MiB, WS_WDN = 28 * MiB;
constexpr size_t WS_WM = 34 * MiB, WS_MEMN = 35 * MiB, WS_KV = 39 * MiB;
constexpr size_t WS_PS1 = 48 * MiB, WS_PS2 = 50 * MiB, WS_PS3 = 52 * MiB, WS_RX = 54 * MiB;
constexpr size_t WS_XB = 64 * MiB, WS_H = 128 * MiB, WS_Y = 288 * MiB, WS_Q = 352 * MiB, WS_O = 416 * MiB, WS_HF = 128 * MiB, WS_END = 480 * MiB;

struct Params {
    const float* in[21];
    float* out;
    unsigned char* ws;
    int ph_lo, ph_hi;
};

__device__ __forceinline__ int lane_id() { unsigned l; asm volatile("v_mbcnt_lo_u32_b32 %0, -1, 0\n\tv_mbcnt_hi_u32_b32 %0, -1, %0" : "=v"(l)); return (int)(l & 63u); }
__device__ __forceinline__ int wave_id() { return __builtin_amdgcn_readfirstlane((int)threadIdx.x >> 6) & 7; }
__device__ __forceinline__ float xor16_add(float v) { const unsigned u = __builtin_bit_cast(unsigned, v); auto r = __builtin_amdgcn_permlane16_swap(u, u, false, false); return __builtin_bit_cast(float, (unsigned)r[0]) + __builtin_bit_cast(float, (unsigned)r[1]); }
__device__ __forceinline__ float xor32_add(float v) { const unsigned u = __builtin_bit_cast(unsigned, v); auto r = __builtin_amdgcn_permlane32_swap(u, u, false, false); return __builtin_bit_cast(float, (unsigned)r[0]) + __builtin_bit_cast(float, (unsigned)r[1]); }
__device__ __forceinline__ float xor16_max(float v) { const unsigned u = __builtin_bit_cast(unsigned, v); auto r = __builtin_amdgcn_permlane16_swap(u, u, false, false); return fmaxf(__builtin_bit_cast(float, (unsigned)r[0]), __builtin_bit_cast(float, (unsigned)r[1])); }
__device__ __forceinline__ float xor32_max(float v) { const unsigned u = __builtin_bit_cast(unsigned, v); auto r = __builtin_amdgcn_permlane32_swap(u, u, false, false); return fmaxf(__builtin_bit_cast(float, (unsigned)r[0]), __builtin_bit_cast(float, (unsigned)r[1])); }
__device__ __forceinline__ float fq_sum(float v) { return xor32_add(xor16_add(v)); }
__device__ __forceinline__ float fq_max(float v) { return xor32_max(xor16_max(v)); }
template <int CTRL> __device__ __forceinline__ float dpp_f(float v) { return __builtin_bit_cast(float, __builtin_amdgcn_update_dpp(0, __builtin_bit_cast(int, v), CTRL, 0xf, 0xf, true)); }
__device__ __forceinline__ float wave_sum(float v) {
    v += dpp_f<0xB1>(v);
    v += dpp_f<0x4E>(v);
    v += dpp_f<0x141>(v);
    v += dpp_f<0x140>(v);
    return fq_sum(v);
}
__device__ __forceinline__ unsigned f2bf(float f) { unsigned u = __builtin_bit_cast(unsigned, f); return (u + 0x7fffu + ((u >> 16) & 1u)) >> 16; }
__device__ __forceinline__ unsigned pk2(float lo, float hi) { return f2bf(lo) | (f2bf(hi) << 16); }
__device__ __forceinline__ float bf_lo(unsigned w) { return __builtin_bit_cast(float, w << 16); }
__device__ __forceinline__ float bf_hi(unsigned w) { return __builtin_bit_cast(float, w & 0xffff0000u); }
__device__ __forceinline__ float bf2f(bf16_t h) { return __builtin_bit_cast(float, (unsigned)h << 16); }
__device__ __forceinline__ float gelu_tanh(float a) {
    const float inner = a * (1.0f + 0.044715f * a * a);
    const float e = __builtin_amdgcn_exp2f(-2.302208198f * inner);
    return a * __builtin_amdgcn_rcpf(1.0f + e);
}
__device__ __forceinline__ float silu(float g) { return g * __builtin_amdgcn_rcpf(1.0f + __builtin_amdgcn_exp2f(-1.4426950408889634f * g)); }
__device__ __forceinline__ float rstd_from_ps(const float* ps, int row) {
    const f32x4* p = (const f32x4*)(ps + (size_t)row * 16);
    const f32x4 a = p[0], b = p[1], c = p[2], d = p[3];
    const float s = ((a[0] + a[1]) + (a[2] + a[3])) + ((b[0] + b[1]) + (b[2] + b[3])) + ((c[0] + c[1]) + (c[2] + c[3])) + ((d[0] + d[1]) + (d[2] + d[3]));
    return __builtin_amdgcn_rsqf(s * (1.0f / D) + EPS);
}

namespace pg8 {
#define PG8_LAS __attribute__((address_space(3)))
constexpr int BM = 256, BK = 64, HALF = 128, HTB = HALF * BK * 2, STAGE_BYTES = 8 * HTB, NXCD = 8, WGM = 8;
__host__ __device__ __forceinline__ int lds_byte(int r, int c) { const int st = (r >> 4) * 2 + (c >> 5), rr = r & 15, cc = c & 31, ob = rr * 64 + cc * 2; return st * 1024 + (ob ^ (((ob >> 9) & 1) << 5)); }
__host__ __device__ __forceinline__ void stage_rc(int b, int& R, int& C) { const int st = b / 1024, sb = b % 1024, swz = sb ^ (((sb >> 9) & 1) << 5); R = (st >> 1) * 16 + swz / 64; C = (st & 1) * 32 + (swz % 64) / 2; }
__host__ __device__ __forceinline__ int perm32(int rho) { const int n = rho >> 4, i = rho & 15; return 8 * (i >> 2) + 4 * n + (i & 3); }

struct Unit { int pm, pn; };
struct Gemm { const bf16_t* A; const bf16_t* Bt; int M, N, K; };

struct StaticOrder {
    int nM, nN, nwg, G, c;
    __host__ __device__ void init(int M_, int N_, int G_, int c_) { nM = M_ / BM; nN = N_ / BM; nwg = nM * nN; G = G_; c = c_; }
    __host__ __device__ bool next(int i, Unit& u) const {
        const long L = (long)i * G + c; if (L >= nwg) return false;
        int wgid = (int)L; { const int q = nwg / NXCD, r = nwg % NXCD, xcd = wgid % NXCD, off = wgid / NXCD; wgid = (xcd < r ? xcd * (q + 1) : r * (q + 1) + (xcd - r) * q) + off; }
        const int nig = WGM * nN, gid = wgid / nig, fm = gid * WGM, gsz = (nM - fm) < WGM ? (nM - fm) : WGM;
        u.pm = fm + ((wgid % nig) % gsz); u.pn = (wgid % nig) / gsz; return true;
    }
    __device__ __forceinline__ void a_ready(const Unit&) const {}
    __device__ __forceinline__ void done(const Unit&) const {}
};

__device__ __forceinline__ unsigned cvt_pk_bf16(float lo, float hi) { unsigned r; asm volatile("v_cvt_pk_bf16_f32 %0, %1, %2" : "=v"(r) : "v"(lo), "v"(hi)); return r; }

struct EpiAct {
    static constexpr bool PERM = true, AFTER_DRAIN = false;
    bf16_t* O; int ldc; int gelu_cols;
    __device__ __forceinline__ void unit_begin(const Unit&, PG8_LAS unsigned char*, int, int) const {}
    __device__ __forceinline__ void operator()(const f32x4 (&acc)[2][2][4][2], const Unit& u, int, PG8_LAS unsigned char*, int wr, int wc, int fr, int fq) const {
        const int row0 = u.pm * BM + wr * 64 + fr, col0 = u.pn * BM + wc * 32 + 8 * fq;
        const bool act = (u.pn * BM) < gelu_cols;
#pragma unroll
        for (int ai = 0; ai < 2; ++ai)
#pragma unroll
            for (int m = 0; m < 4; ++m) { bf16_t* rowp = O + (size_t)(row0 + ai * HALF + m * 16) * ldc + col0;
#pragma unroll
                for (int bj = 0; bj < 2; ++bj) { f32x4 v0 = acc[ai][bj][m][0], v1 = acc[ai][bj][m][1];
                    if (act) {
#pragma unroll
                        for (int i = 0; i < 4; ++i) { v0[i] = gelu_tanh(v0[i]); v1[i] = gelu_tanh(v1[i]); } }
                    u32x4 w; w.x = cvt_pk_bf16(v0[0], v0[1]); w.y = cvt_pk_bf16(v0[2], v0[3]); w.z = cvt_pk_bf16(v1[0], v1[1]); w.w = cvt_pk_bf16(v1[2], v1[3]);
                    *(u32x4*)(rowp + bj * HALF) = w; } }
    }
};
__device__ __forceinline__ void rs_dma(const float* ps, const Unit& u, PG8_LAS unsigned char* lds, int wid, int lane) {
    if (wid >= 4) {
#pragma unroll
        for (int i = 0; i < 4; ++i) { const int L0 = ((wid - 4) * 4 + i) * 1024;
            __builtin_amdgcn_global_load_lds((const unsigned*)((const char*)ps + (size_t)u.pm * 16384 + L0 + lane * 16), (PG8_LAS unsigned*)(lds + STAGE_BYTES + L0), 16, 0, 0); } }
}
__device__ __forceinline__ float rs_get(PG8_LAS unsigned char* lds, int r) {
    const PG8_LAS f32x4* p = (const PG8_LAS f32x4*)(lds + STAGE_BYTES + r * 64);
    const f32x4 a = p[0], b = p[1], c = p[2], d = p[3];
    const float s = ((a[0] + a[1]) + (a[2] + a[3])) + ((b[0] + b[1]) + (b[2] + b[3])) + ((c[0] + c[1]) + (c[2] + c[3])) + ((d[0] + d[1]) + (d[2] + d[3]));
    return __builtin_amdgcn_rsqf(s * (1.0f / D) + EPS);
}
struct EpiRowScale {
    static constexpr bool PERM = true, AFTER_DRAIN = false;
    bf16_t* O; int ldc; const float* ps; float scale;
    __device__ __forceinline__ void unit_begin(const Unit& u, PG8_LAS unsigned char* lds, int wid, int lane) const { rs_dma(ps, u, lds, wid, lane); }
    __device__ __forceinline__ void operator()(const f32x4 (&acc)[2][2][4][2], const Unit& u, int ui, PG8_LAS unsigned char* lds, int wr, int wc, int fr, int fq) const {
        const int row0 = u.pm * BM + wr * 64 + fr, col0 = u.pn * BM + wc * 32 + 8 * fq;
#pragma unroll
        for (int ai = 0; ai < 2; ++ai)
#pragma unroll
            for (int m = 0; m < 4; ++m) { const int row = row0 + ai * HALF + m * 16; const float rs = rs_get(lds, wr * 64 + fr + ai * HALF + m * 16) * scale;
                bf16_t* rowp = O + (size_t)row * ldc + col0;
#pragma unroll
                for (int bj = 0; bj < 2; ++bj) { const f32x4 v0 = acc[ai][bj][m][0] * rs, v1 = acc[ai][bj][m][1] * rs;
                    u32x4 w; w.x = cvt_pk_bf16(v0[0], v0[1]); w.y = cvt_pk_bf16(v0[2], v0[3]); w.z = cvt_pk_bf16(v1[0], v1[1]); w.w = cvt_pk_bf16(v1[2], v1[3]);
                    *(u32x4*)(rowp + bj * HALF) = w; } }
    }
};
struct EpiGU {
    static constexpr bool PERM = true, AFTER_DRAIN = false;
    bf16_t* O; const float* ps;
    __device__ __forceinline__ void unit_begin(const Unit& u, PG8_LAS unsigned char* lds, int wid, int lane) const { rs_dma(ps, u, lds, wid, lane); }
    __device__ __forceinline__ void operator()(const f32x4 (&acc)[2][2][4][2], const Unit& u, int ui, PG8_LAS unsigned char* lds, int wr, int wc, int fr, int fq) const {
        const int row0 = u.pm * BM + wr * 64 + fr, col0 = u.pn * HALF + wc * 32 + 8 * fq;
#pragma unroll
        for (int ai = 0; ai < 2; ++ai)
#pragma unroll
            for (int m = 0; m < 4; ++m) { const int row = row0 + ai * HALF + m * 16; const float rs = rs_get(lds, wr * 64 + fr + ai * HALF + m * 16);
                f32x4 h0, h1;
#pragma unroll
                for (int i = 0; i < 4; ++i) { h0[i] = silu(acc[ai][0][m][0][i] * rs) * (acc[ai][1][m][0][i] * rs); h1[i] = silu(acc[ai][0][m][1][i] * rs) * (acc[ai][1][m][1][i] * rs); }
                u32x4 w; w.x = cvt_pk_bf16(h0[0], h0[1]); w.y = cvt_pk_bf16(h0[2], h0[3]); w.z = cvt_pk_bf16(h1[0], h1[1]); w.w = cvt_pk_bf16(h1[2], h1[3]);
                *(u32x4*)(O + (size_t)row * DFF + col0) = w; }
    }
};
struct EpiRes {
    static constexpr bool PERM = true, AFTER_DRAIN = false;
    const bf16_t* base; bf16_t* xb; float* ps; const float* rowscale;
    __device__ __forceinline__ void unit_begin(const Unit&, PG8_LAS unsigned char*, int, int) const {}
    __device__ __forceinline__ void operator()(const f32x4 (&acc)[2][2][4][2], const Unit& u, int, PG8_LAS unsigned char*, int wr, int wc, int fr, int fq) const {
        const int row0 = u.pm * BM + wr * 64 + fr, col0 = u.pn * BM + wc * 32 + 8 * fq;
        u32x4 bv[4][2]; float sc[4];
#pragma unroll
        for (int m = 0; m < 4; ++m) { const int row = row0 + m * 16; sc[m] = rowscale ? rowscale[row] : 1.0f;
#pragma unroll
            for (int bj = 0; bj < 2; ++bj) bv[m][bj] = *(const u32x4*)(base + (size_t)row * D + col0 + bj * HALF); }
#pragma unroll
        for (int ai = 0; ai < 2; ++ai)
#pragma unroll
            for (int m = 0; m < 4; ++m) { const int row = row0 + ai * HALF + m * 16; float ss = 0.f; const float k = sc[m];
#pragma unroll
                for (int bj = 0; bj < 2; ++bj) { const u32x4 r = bv[m][bj]; const f32x4 a0 = acc[ai][bj][m][0], a1 = acc[ai][bj][m][1];
                    f32x4 o0, o1;
                    o0[0] = bf_lo(r.x) * k + a0[0]; o0[1] = bf_hi(r.x) * k + a0[1]; o0[2] = bf_lo(r.y) * k + a0[2]; o0[3] = bf_hi(r.y) * k + a0[3];
                    o1[0] = bf_lo(r.z) * k + a1[0]; o1[1] = bf_hi(r.z) * k + a1[1]; o1[2] = bf_lo(r.w) * k + a1[2]; o1[3] = bf_hi(r.w) * k + a1[3];
                    ss += ((o0[0] * o0[0] + o0[1] * o0[1]) + (o0[2] * o0[2] + o0[3] * o0[3])) + ((o1[0] * o1[0] + o1[1] * o1[1]) + (o1[2] * o1[2] + o1[3] * o1[3]));
                    u32x4 w; w.x = cvt_pk_bf16(o0[0], o0[1]); w.y = cvt_pk_bf16(o0[2], o0[3]); w.z = cvt_pk_bf16(o1[0], o1[1]); w.w = cvt_pk_bf16(o1[2], o1[3]);
                    *(u32x4*)(xb + (size_t)row * D + col0 + bj * HALF) = w; }
                if (ai == 0) { sc[m] = rowscale ? rowscale[row + HALF] : 1.0f;
#pragma unroll
                    for (int bj = 0; bj < 2; ++bj) bv[m][bj] = *(const u32x4*)(base + (size_t)(row + HALF) * D + col0 + bj * HALF); }
                ss = fq_sum(ss);
                if (fq == 0) ps[(size_t)row * 16 + u.pn * 4 + wc] = ss; }
    }
};

template <class Epi, class Sched, bool ALIGN_EPI = false, bool SP2 = false>
__device__ __forceinline__ void gemm_phase(PG8_LAS unsigned char* lds, const Gemm g, const Sched& S, const Epi& E, int wave_) {
    int l_ = lane_id(); asm volatile("" : "+v"(l_)); l_ &= 63;
    const int wid = wave_ & 7, tid = wid * 64 + l_, lane = tid & 63, wr = wid >> 2, wc = wid & 3, fr = lane & 15, fq = lane >> 4;
    const int K = g.K, nt = K / BK;
    unsigned voffA[2], voffB[2];
#pragma unroll
    for (int i = 0; i < 2; ++i) { int R, C; stage_rc(tid * 16 + i * 8192, R, C); const int Rb = Epi::PERM ? ((R & ~31) + perm32(R & 31)) : R;
        voffA[i] = (unsigned)(R * K + C) * 2u; voffB[i] = (unsigned)(Rb * K + C) * 2u; }
    const size_t kstep = (size_t)(BK * 2);
    const size_t hstep = (size_t)HALF * K * 2;
    const size_t tstep = 2 * hstep;
    const unsigned ldsw = (unsigned)wid * 1024u;
    const int aoff = lds_byte(wr * 64 + fr, fq * 8), boff = lds_byte(wc * 32 + fr, fq * 8);
#define PG8_SA(b, h) (((b) * 2 + (h)) * HTB)
#define PG8_SB(b, h) ((4 + (b) * 2 + (h)) * HTB)
#define PG8_STAGE(bufoff, gbase, voff) do { _Pragma("unroll") for (int _i = 0; _i < 2; ++_i) \
        __builtin_amdgcn_global_load_lds((const unsigned*)((const char*)(gbase) + (voff)[_i]), (PG8_LAS unsigned*)(lds + (bufoff) + ldsw + _i * 8192), 16, 0, 0); } while (0)
#define PG8_LDA(dst, b, h) do { _Pragma("unroll") for (int m = 0; m < 4; ++m) _Pragma("unroll") for (int k = 0; k < 2; ++k) dst[m][k] = *(const PG8_LAS bf16x8*)(lds + PG8_SA(b, h) + aoff + m * 2048 + k * 1024); } while (0)
#define PG8_LDB(dst, b, h) do { _Pragma("unroll") for (int n = 0; n < 2; ++n) _Pragma("unroll") for (int k = 0; k < 2; ++k) dst[n][k] = *(const PG8_LAS bf16x8*)(lds + PG8_SB(b, h) + boff + n * 2048 + k * 1024); } while (0)
#define PG8_MMA(ai, bj, At, Bt) do { __builtin_amdgcn_s_setprio(1); _Pragma("unroll") for (int m = 0; m < 4; ++m) _Pragma("unroll") for (int n = 0; n < 2; ++n) _Pragma("unroll") for (int k = 0; k < 2; ++k) \
        acc[ai][bj][m][n] = __builtin_amdgcn_mfma_f32_16x16x32_bf16(Bt[n][k], At[m][k], acc[ai][bj][m][n], 0, 0, 0); __builtin_amdgcn_s_setprio(0); } while (0)
#define PG8_WAIT_V(n) asm volatile("s_waitcnt vmcnt(" #n ")" ::: "memory")
#define PG8_WAIT_L(n) asm volatile("s_waitcnt lgkmcnt(" #n ")" ::: "memory")
#define PG8_BAR __builtin_amdgcn_s_barrier()
#define PG8_SCHED __builtin_amdgcn_sched_barrier(0)
    Unit cur, nxt; int ui = 0;
    if (!S.next(0, cur)) return;
    f32x4 acc[2][2][4][2];
#pragma unroll
    for (int a = 0; a < 2; ++a)
#pragma unroll
        for (int b = 0; b < 2; ++b)
#pragma unroll
            for (int m = 0; m < 4; ++m)
#pragma unroll
                for (int n = 0; n < 2; ++n) acc[a][b][m][n] = (f32x4){0.f, 0.f, 0.f, 0.f};
    bf16x8 At[4][2], B0[2][2], B1[2][2];
    const char* cA = (const char*)g.A + (size_t)cur.pm * tstep; const char* cB = (const char*)g.Bt + (size_t)cur.pn * tstep;
    S.a_ready(cur); E.unit_begin(cur, lds, wid, lane);
    if constexpr (SP2) {
        PG8_STAGE(PG8_SB(0, 0), cB, voffB); PG8_STAGE(PG8_SB(0, 1), cB + hstep, voffB); PG8_STAGE(PG8_SA(0, 0), cA, voffA); PG8_STAGE(PG8_SA(0, 1), cA + hstep, voffA);
        if (wr == 1) PG8_BAR;
        PG8_WAIT_V(2); PG8_BAR;
        PG8_STAGE(PG8_SB(1, 0), cB + kstep, voffB); PG8_STAGE(PG8_SA(1, 0), cA + kstep, voffA); PG8_STAGE(PG8_SB(1, 1), cB + hstep + kstep, voffB);
        PG8_WAIT_V(6); PG8_BAR;
    } else {
        PG8_STAGE(PG8_SB(0, 0), cB, voffB); PG8_STAGE(PG8_SA(0, 0), cA, voffA); PG8_STAGE(PG8_SB(0, 1), cB + hstep, voffB); PG8_STAGE(PG8_SA(0, 1), cA + hstep, voffA);
        if (wr == 1) PG8_BAR;
        PG8_WAIT_V(4); PG8_BAR;
        PG8_STAGE(PG8_SB(1, 0), cB + kstep, voffB); PG8_STAGE(PG8_SA(1, 0), cA + kstep, voffA); PG8_STAGE(PG8_SB(1, 1), cB + hstep + kstep, voffB);
        PG8_WAIT_V(6); PG8_BAR;
    }
    for (;;) {
        const bool has_next = S.next(ui + 1, nxt);
        const char* nA = has_next ? (const char*)g.A + (size_t)nxt.pm * tstep : cA; const char* nB = has_next ? (const char*)g.Bt + (size_t)nxt.pn * tstep : cB;
        for (int t = 0; t < nt; t += 2) {
            const bool last = (t == nt - 2);
            const char* a1 = cA + (size_t)(t + 1) * kstep;
            const char* a2 = last ? nA : cA + (size_t)(t + 2) * kstep; const char* b2 = last ? nB : cB + (size_t)(t + 2) * kstep;
            const char* a3 = a2 + kstep; const char* b3 = b2 + kstep;
            if (last && has_next) S.a_ready(nxt);
            if constexpr (SP2) {
            PG8_LDB(B0, 0, 0); PG8_LDB(B1, 0, 1); PG8_SCHED; PG8_LDA(At, 0, 0); PG8_STAGE(PG8_SA(1, 1), a1 + hstep, voffA);
            PG8_WAIT_V(8); PG8_WAIT_L(0); PG8_BAR; PG8_MMA(0, 0, At, B0); PG8_MMA(0, 1, At, B1); PG8_BAR; PG8_SCHED;
            PG8_LDA(At, 0, 1); PG8_STAGE(PG8_SB(0, 0), b2, voffB); PG8_STAGE(PG8_SB(0, 1), b2 + hstep, voffB); PG8_STAGE(PG8_SA(0, 0), a2, voffA);
            PG8_WAIT_V(8); PG8_WAIT_L(0); PG8_BAR; PG8_MMA(1, 0, At, B0); PG8_MMA(1, 1, At, B1); PG8_BAR; PG8_SCHED;
            PG8_LDB(B0, 1, 0); PG8_LDB(B1, 1, 1); PG8_SCHED; PG8_LDA(At, 1, 0); PG8_STAGE(PG8_SA(0, 1), a2 + hstep, voffA);
            PG8_WAIT_V(8); PG8_WAIT_L(0); PG8_BAR; PG8_MMA(0, 0, At, B0); PG8_MMA(0, 1, At, B1); PG8_BAR; PG8_SCHED;
            PG8_LDA(At, 1, 1); PG8_STAGE(PG8_SB(1, 0), b3, voffB); PG8_STAGE(PG8_SB(1, 1), b3 + hstep, voffB); PG8_STAGE(PG8_SA(1, 0), a3, voffA);
            PG8_WAIT_V(8); PG8_WAIT_L(0); PG8_BAR; PG8_MMA(1, 0, At, B0); PG8_MMA(1, 1, At, B1); PG8_BAR; PG8_SCHED;
            } else {
            PG8_LDB(B0, 0, 0); PG8_SCHED; PG8_LDA(At, 0, 0); PG8_STAGE(PG8_SA(1, 1), a1 + hstep, voffA);
            PG8_WAIT_L(8); PG8_BAR; PG8_WAIT_L(0); PG8_MMA(0, 0, At, B0); PG8_BAR; PG8_SCHED;
            PG8_LDB(B1, 0, 1); PG8_STAGE(PG8_SB(0, 0), b2, voffB);
            PG8_BAR; PG8_WAIT_L(0); PG8_MMA(0, 1, At, B1); PG8_BAR;
            PG8_LDA(At, 0, 1); PG8_STAGE(PG8_SA(0, 0), a2, voffA);
            PG8_BAR; PG8_WAIT_L(0); PG8_MMA(1, 0, At, B0); PG8_BAR; PG8_SCHED;
            PG8_STAGE(PG8_SB(0, 1), b2 + hstep, voffB);
            PG8_WAIT_V(6); PG8_BAR; PG8_MMA(1, 1, At, B1); PG8_BAR;
            PG8_LDB(B0, 1, 0); PG8_SCHED; PG8_LDA(At, 1, 0); PG8_STAGE(PG8_SA(0, 1), a2 + hstep, voffA);
            PG8_WAIT_L(8); PG8_BAR; PG8_WAIT_L(0); PG8_MMA(0, 0, At, B0); PG8_BAR; PG8_SCHED;
            PG8_LDB(B1, 1, 1); PG8_STAGE(PG8_SB(1, 0), b3, voffB);
            PG8_BAR; PG8_WAIT_L(0); PG8_MMA(0, 1, At, B1); PG8_BAR;
            PG8_LDA(At, 1, 1); PG8_STAGE(PG8_SA(1, 0), a3, voffA);
            PG8_BAR; PG8_WAIT_L(0); PG8_MMA(1, 0, At, B0); PG8_BAR; PG8_SCHED;
            PG8_STAGE(PG8_SB(1, 1), b3 + hstep, voffB);
            PG8_WAIT_V(6); PG8_BAR; PG8_MMA(1, 1, At, B1); PG8_BAR;
            }
        }
        if constexpr (ALIGN_EPI) { if (wr == 0) PG8_BAR; }
        E(acc, cur, ui, lds, wr, wc, fr, fq); S.done(cur);
        if (!has_next) break;
#pragma unroll
        for (int a = 0; a < 2; ++a)
#pragma unroll
            for (int b = 0; b < 2; ++b)
#pragma unroll
                for (int m = 0; m < 4; ++m)
#pragma unroll
                    for (int n = 0; n < 2; ++n) acc[a][b][m][n] = (f32x4){0.f, 0.f, 0.f, 0.f};
        cur = nxt; cA = nA; cB = nB; ++ui;
        if constexpr (ALIGN_EPI) { if (wr == 1) PG8_BAR; }
        E.unit_begin(cur, lds, wid, lane);
    }
    PG8_WAIT_V(0);
    if constexpr (!ALIGN_EPI) { if (wr == 0) PG8_BAR; }
    PG8_BAR;
#undef PG8_SA
#undef PG8_SB
#undef PG8_STAGE
#undef PG8_LDA
#undef PG8_LDB
#undef PG8_MMA
#undef PG8_WAIT_V
#undef PG8_WAIT_L
#undef PG8_BAR
#undef PG8_SCHED
}
}

constexpr int NWAVES = 8, NTHREADS = NWAVES * 64;
constexpr int RING_BYTES = 131072;
constexpr int LDS_BYTES = 147968;
struct Frame {
    LAS unsigned char* lds;
    int tid, lane, wave, G, bid;
    const float* const* in;
    float* out;
    unsigned char* ws;
};
enum InIdx { I_X = 0, I_MEM, I_LN_MIX_G, I_W_IN, I_SGU_LN_G, I_SGU_LN_B, I_W_SPATIAL, I_B_SPATIAL, I_CONV_W, I_GRP_A, I_GRP_B, I_W_OUT, I_LN_ATTN_G, I_LN_MEM_G,
             I_W_Q, I_W_KV, I_W_O, I_LN_FFN_G, I_W_GU, I_W_DOWN, I_LN_FINAL_G };

__device__ __forceinline__ void p0_transpose_item(const float* W, int K, int N, bf16_t* WT, const float* gain, int k0, int sc0, int dn0, LAS float* scr, int lane) {
    const int rq = lane >> 4, cq = lane & 15;
    f32x4 v[16];
#pragma unroll
    for (int i = 0; i < 16; ++i) v[i] = *(const f32x4*)(W + (size_t)(k0 + 4 * i + rq) * N + sc0 + 4 * cq);
    if (gain) {
#pragma unroll
        for (int i = 0; i < 16; ++i) v[i] = v[i] * gain[k0 + 4 * i + rq]; }
#pragma unroll
    for (int i = 0; i < 16; ++i) { LAS float* d = scr + (4 * i + rq) * 65 + 4 * cq; d[0] = v[i][0]; d[1] = v[i][1]; d[2] = v[i][2]; d[3] = v[i][3]; }
    asm volatile("s_waitcnt lgkmcnt(0)" ::: "memory");
    const int c = lane & 7;
#pragma unroll
    for (int j = 0; j < 8; ++j) { const int n = (lane >> 3) + 8 * j; const LAS float* s_ = scr + (8 * c) * 65 + n;
        u32x4 o; o.x = pk2(s_[0 * 65], s_[1 * 65]); o.y = pk2(s_[2 * 65], s_[3 * 65]); o.z = pk2(s_[4 * 65], s_[5 * 65]); o.w = pk2(s_[6 * 65], s_[7 * 65]);
        *(u32x4*)(WT + (size_t)(dn0 + n) * K + k0 + 8 * c) = o; }
    asm volatile("s_waitcnt lgkmcnt(0)" ::: "memory");
}
template <int NR>
__device__ __forceinline__ void rms_rows_to_bf16(const float* x, bf16_t* o, float* inv, int m0, int stride, int lane) {
    f32x4 v[NR][4];
#pragma unroll
    for (int r = 0; r < NR; ++r) { const f32x4* xr = (const f32x4*)(x + (size_t)(m0 + r * stride) * D) + lane;
#pragma unroll
        for (int j = 0; j < 4; ++j) v[r][j] = xr[64 * j]; }
#pragma unroll
    for (int r = 0; r < NR; ++r) { float s = 0.f;
#pragma unroll
        for (int j = 0; j < 4; ++j) s += (v[r][j][0] * v[r][j][0] + v[r][j][1] * v[r][j][1]) + (v[r][j][2] * v[r][j][2] + v[r][j][3] * v[r][j][3]);
        const float ms = wave_sum(s) * (1.f / D) + EPS; const float rstd = __builtin_amdgcn_rsqf(ms);
        if (inv && lane == 0) inv[m0 + r * stride] = ms * rstd;
        unsigned long long* o8 = (unsigned long long*)(o + (size_t)(m0 + r * stride) * D) + lane;
#pragma unroll
        for (int j = 0; j < 4; ++j) o8[64 * j] = (unsigned long long)pk2(v[r][j][0] * rstd, v[r][j][1] * rstd) | ((unsigned long long)pk2(v[r][j][2] * rstd, v[r][j][3] * rstd) << 32); }
}
__device__ __forceinline__ void p0_prologue(Frame& F) {
    LAS float* scr = (LAS float*)(F.lds + F.wave * 16640);
    const int gw = F.bid * NWAVES + F.wave, NGW = F.G * NWAVES;
    bf16_t* Win_t = (bf16_t*)(F.ws + WS_WIN); bf16_t* Wout_t = (bf16_t*)(F.ws + WS_WOUT); bf16_t* Wq_t = (bf16_t*)(F.ws + WS_WQ); bf16_t* Wkv_t = (bf16_t*)(F.ws + WS_WKV);
    bf16_t* Wo_t = (bf16_t*)(F.ws + WS_WO); bf16_t* Wgu_t = (bf16_t*)(F.ws + WS_WGU); bf16_t* Wdn_t = (bf16_t*)(F.ws + WS_WDN);
    constexpr int IT_IN = (D / 64) * (NIN / 64), IT_SQ = (D / 64) * (D / 64), IT_KV = (D / 64) * (2 * D / 64), IT_GU = (D / 64) * (NGU / 64), IT_DN = (DFF / 64) * (D / 64);
    constexpr int NITEMS = IT_IN + 3 * IT_SQ + IT_KV + IT_GU + IT_DN;
    for (int it = gw; it < NITEMS; it += NGW) {
        int r = it;
        if (r < IT_IN) { const int nb = r % (NIN / 64), kb = r / (NIN / 64); p0_transpose_item(F.in[I_W_IN], D, NIN, Win_t, F.in[I_LN_MIX_G], 64 * kb, 64 * nb, 64 * nb, scr, F.lane); continue; } r -= IT_IN;
        if (r < IT_SQ) { const int nb = r % (D / 64), kb = r / (D / 64); const int k0 = 64 * kb;
            const float* gain = (k0 < 512) ? F.in[I_GRP_A] : (F.in[I_GRP_B] - 512);
            p0_transpose_item(F.in[I_W_OUT], D, D, Wout_t, gain, k0, 64 * nb, 64 * nb, scr, F.lane); continue; } r -= IT_SQ;
        if (r < IT_SQ) { const int nb = r % (D / 64), kb = r / (D / 64); p0_transpose_item(F.in[I_W_Q], D, D, Wq_t, F.in[I_LN_ATTN_G], 64 * kb, 64 * nb, 64 * nb, scr, F.lane); continue; } r -= IT_SQ;
        if (r < IT_SQ) { const int nb = r % (D / 64), kb = r / (D / 64); p0_transpose_item(F.in[I_W_O], D, D, Wo_t, nullptr, 64 * kb, 64 * nb, 64 * nb, scr, F.lane); continue; } r -= IT_SQ;
        if (r < IT_KV) { const int nb = r % (2 * D / 64), kb = r / (2 * D / 64); p0_transpose_item(F.in[I_W_KV], D, 2 * D, Wkv_t, F.in[I_LN_MEM_G], 64 * kb, 64 * nb, 64 * nb, scr, F.lane); continue; } r -= IT_KV;
        if (r < IT_GU) { const int nb = r % (NGU / 64), kb = r / (NGU / 64); const int dn0 = 64 * nb, tile = dn0 >> 8, j = dn0 & 255;
            const int sc0 = (j < 128) ? (128 * tile + j) : (DFF + 128 * tile + (j - 128));
            p0_transpose_item(F.in[I_W_GU], D, NGU, Wgu_t, F.in[I_LN_FFN_G], 64 * kb, sc0, dn0, scr, F.lane); continue; } r -= IT_GU;
        { const int nb = r % (D / 64), kb = r / (D / 64); p0_transpose_item(F.in[I_W_DOWN], DFF, D, Wdn_t, nullptr, 64 * kb, 64 * nb, 64 * nb, scr, F.lane); }
    }
    { bf16_t* Wm = (bf16_t*)(F.ws + WS_WM); const float* wsp = F.in[I_W_SPATIAL];
      for (int i = F.bid * NTHREADS + F.tid; i < 4 * 128 * 128; i += F.G * NTHREADS) { const int s = i & 127, t = (i >> 7) & 127; Wm[i] = (bf16_t)(s <= t ? f2bf(wsp[i]) : 0u); } }
    bf16_t* XB = (bf16_t*)(F.ws + WS_XB); bf16_t* MEMN = (bf16_t*)(F.ws + WS_MEMN);
    float* RX = (float*)(F.ws + WS_RX);
    for (int m = gw; m < M; m += 4 * NGW) rms_rows_to_bf16<4>(F.in[I_X], XB, RX, m, NGW, F.lane);
    for (int m = gw; m < MROWS; m += NGW) rms_rows_to_bf16<1>(F.in[I_MEM], MEMN, nullptr, m, NGW, F.lane);
}

constexpr int VS = 1040;
__device__ __forceinline__ s16x4 tr_read(const LAS unsigned char* p) { return __builtin_bit_cast(s16x4, __builtin_amdgcn_ds_read_tr16_b64_v4i16((LAS s16x4*)p)); }
__device__ __forceinline__ void unpack8(const u32x4 w, float* v) { v[0] = bf_lo(w.x); v[1] = bf_hi(w.x); v[2] = bf_lo(w.y); v[3] = bf_hi(w.y); v[4] = bf_lo(w.z); v[5] = bf_hi(w.z); v[6] = bf_lo(w.w); v[7] = bf_hi(w.w); }
__device__ __forceinline__ void p2_sgu_conv(Frame& F) {
    const bf16_t* H = (const bf16_t*)(F.ws + WS_H); bf16_t* Y = (bf16_t*)(F.ws + WS_Y); const bf16_t* Wm = (const bf16_t*)(F.ws + WS_WM);
    const int w = F.wave;
    for (int ch = F.bid; ch < NCHUNK; ch += F.G) {
        int lane = F.lane; asm volatile("" : "+v"(lane));
        const int fr = lane & 15, fq = lane >> 4;
        const int row0 = ch * CHUNK; const bool first = (ch % (SEQ / CHUNK)) == 0;
        const bf16_t* Hc = H + (size_t)row0 * NIN;
        { float lg[8], lb[8];
          { const f32x4* p = (const f32x4*)(F.in[I_SGU_LN_G] + 8 * lane); f32x4 a = p[0], b = p[1]; for (int i = 0; i < 4; ++i) { lg[i] = a[i]; lg[4 + i] = b[i]; }
            p = (const f32x4*)(F.in[I_SGU_LN_B] + 8 * lane); a = p[0]; b = p[1]; for (int i = 0; i < 4; ++i) { lb[i] = a[i]; lb[4 + i] = b[i]; } }
#pragma unroll 4
        for (int r = 0; r < 16; ++r) { const int row = 16 * w + r;
            float v[8]; unpack8(*(const u32x4*)(Hc + (size_t)row * NIN + 512 + 8 * lane), v);
            float s = 0.f;
#pragma unroll
            for (int i = 0; i < 8; ++i) s += v[i];
            const float mu = wave_sum(s) * (1.f / 512.f); float q = 0.f;
#pragma unroll
            for (int i = 0; i < 8; ++i) { v[i] -= mu; q += v[i] * v[i]; }
            const float rstd = __builtin_amdgcn_rsqf(wave_sum(q) * (1.f / 512.f) + EPS);
#pragma unroll
            for (int i = 0; i < 8; ++i) v[i] = v[i] * rstd * lg[i] + lb[i];
            u32x4 o; o.x = pk2(v[0], v[1]); o.y = pk2(v[2], v[3]); o.z = pk2(v[4], v[5]); o.w = pk2(v[6], v[7]);
            *(LAS u32x4*)(F.lds + row * VS + lane * 16) = o; } }
        { float z1[8], z2[8], cw0[8], cw1[8], cw2[8];
          { const f32x4* p = (const f32x4*)(F.in[I_CONV_W] + 8 * lane); f32x4 a = p[0], b = p[1]; for (int i = 0; i < 4; ++i) { cw0[i] = a[i]; cw0[4 + i] = b[i]; }
            p = (const f32x4*)(F.in[I_CONV_W] + 512 + 8 * lane); a = p[0]; b = p[1]; for (int i = 0; i < 4; ++i) { cw1[i] = a[i]; cw1[4 + i] = b[i]; }
            p = (const f32x4*)(F.in[I_CONV_W] + 1024 + 8 * lane); a = p[0]; b = p[1]; for (int i = 0; i < 4; ++i) { cw2[i] = a[i]; cw2[4 + i] = b[i]; } }
#pragma unroll
          for (int i = 0; i < 8; ++i) { z1[i] = 0.f; z2[i] = 0.f; }
          if (!(first && w == 0)) {
              float a[8], b[8];
              unpack8(*(const u32x4*)(Hc + (long)(16 * w - 2) * NIN + 1536 + 8 * lane), a); unpack8(*(const u32x4*)(Hc + (long)(16 * w - 2) * NIN + 2048 + 8 * lane), b);
#pragma unroll
              for (int i = 0; i < 8; ++i) z2[i] = a[i] * b[i];
              unpack8(*(const u32x4*)(Hc + (long)(16 * w - 1) * NIN + 1536 + 8 * lane), a); unpack8(*(const u32x4*)(Hc + (long)(16 * w - 1) * NIN + 2048 + 8 * lane), b);
#pragma unroll
              for (int i = 0; i < 8; ++i) z1[i] = a[i] * b[i];
          }
#pragma unroll 4
          for (int r = 0; r < 16; ++r) { const int row = 16 * w + r; const bf16_t* hp = Hc + (size_t)row * NIN + 8 * lane;
              float gb[8], gc[8], vl[8]; unpack8(*(const u32x4*)(hp + 1024), gb); unpack8(*(const u32x4*)(hp + 1536), gc); unpack8(*(const u32x4*)(hp + 2048), vl);
              float yb[8]; float ss = 0.f;
#pragma unroll
              for (int i = 0; i < 8; ++i) { const float z0 = gc[i] * vl[i]; const float cv = cw0[i] * z2[i] + cw1[i] * z1[i] + cw2[i] * z0; yb[i] = gb[i] * cv; ss += yb[i] * yb[i]; z2[i] = z1[i]; z1[i] = z0; }
              const float rs = __builtin_amdgcn_rsqf(wave_sum(ss) * (1.f / 512.f) + EPS);
              u32x4 o; o.x = pk2(yb[0] * rs, yb[1] * rs); o.y = pk2(yb[2] * rs, yb[3] * rs); o.z = pk2(yb[4] * rs, yb[5] * rs); o.w = pk2(yb[6] * rs, yb[7] * rs);
              *(u32x4*)(Y + (size_t)(row0 + row) * D + 512 + 8 * lane) = o; } }
        __syncthreads();
        { f32x4 acc[32];
#pragma unroll
          for (int i = 0; i < 32; ++i) acc[i] = (f32x4){0.f, 0.f, 0.f, 0.f};
          const int T0 = 16 * w, nks = (w >> 1) + 1;
          const int q = (lane & 15) >> 2, p = lane & 3;
          for (int ks = 0; ks < nks; ++ks) {
              const LAS unsigned char* vb = F.lds + (32 * ks + 8 * fq + q) * VS + 8 * p;
#pragma unroll
              for (int h = 0; h < 4; ++h) {
                  const bf16x8 wf = *(const bf16x8*)(Wm + ((size_t)(h * 128 + T0 + fr) * 128 + 32 * ks + 8 * fq));
#pragma unroll
                  for (int nt = 0; nt < 8; ++nt) { const int c0 = 128 * h + 16 * nt;
                      const s16x4 lo = tr_read(vb + c0 * 2), hi = tr_read(vb + 4 * VS + c0 * 2);
                      const bf16x8 vf = (bf16x8){lo[0], lo[1], lo[2], lo[3], hi[0], hi[1], hi[2], hi[3]};
                      acc[h * 8 + nt] = __builtin_amdgcn_mfma_f32_16x16x32_bf16(vf, wf, acc[h * 8 + nt], 0, 0, 0); } } }
          const int trow = T0 + fr; const bf16_t* up = Hc + (size_t)trow * NIN; float ss = 0.f;
#pragma unroll
          for (int h = 0; h < 4; ++h) { const float bs = F.in[I_B_SPATIAL][h * 128 + trow];
#pragma unroll
              for (int nt = 0; nt < 8; ++nt) { const int c = 128 * h + 16 * nt + 4 * fq; const u32x2 uw = *(const u32x2*)(up + c);
                  f32x4 a = acc[h * 8 + nt]; a[0] = bf_lo(uw.x) * (a[0] + bs); a[1] = bf_hi(uw.x) * (a[1] + bs); a[2] = bf_lo(uw.y) * (a[2] + bs); a[3] = bf_hi(uw.y) * (a[3] + bs);
                  ss += (a[0] * a[0] + a[1] * a[1]) + (a[2] * a[2] + a[3] * a[3]); acc[h * 8 + nt] = a; }
              asm volatile("" ::: "memory"); }
          ss = fq_sum(ss);
          const float rs = __builtin_amdgcn_rsqf(ss * (1.f / 512.f) + EPS);
          bf16_t* yp = Y + (size_t)(row0 + trow) * D;
#pragma unroll
          for (int i = 0; i < 32; ++i) { const int c = 16 * i + 4 * fq; const f32x4 a = acc[i] * rs; u32x2 o; o.x = pk2(a[0], a[1]); o.y = pk2(a[2], a[3]); *(u32x2*)(yp + c) = o; } }
        __syncthreads();
    }
}

constexpr int KS_B = 528, HB_B = 128 * KS_B;
__device__ __forceinline__ void att_issue(u32x4 (&v)[16], const bf16_t* src, int tid) {
    const unsigned voff = (unsigned)(tid >> 5) * 4096u + (unsigned)(tid & 31) * 16u;
#pragma unroll
    for (int i = 0; i < 16; ++i) v[i] = *(const u32x4*)((const char*)src + (size_t)i * 65536 + voff);
}
__device__ __forceinline__ void att_write(LAS unsigned char* lds, const u32x4 (&v)[16], int tid) {
    LAS unsigned char* d = lds + (tid >> 5) * KS_B + (tid & 31) * 16;
#pragma unroll
    for (int i = 0; i < 16; ++i) *(LAS u32x4*)(d + i * 16 * KS_B) = v[i];
}
__device__ __forceinline__ void p5_attention(Frame& F) {
    const bf16_t* Q = (const bf16_t*)(F.ws + WS_Q); const bf16_t* KV = (const bf16_t*)(F.ws + WS_KV); bf16_t* O = (bf16_t*)(F.ws + WS_O);
    const int lane = F.lane, w = F.wave, fr = lane & 15, fq = lane >> 4, q4 = (lane & 15) >> 2, p4 = lane & 3;
    constexpr int NUNITS = BATCH * 4 * (SEQ / 128);
    u32x4 sv[16]; bf16x8 qf[8];
    int id = F.bid;
    if (id < NUNITS) { const int bh = id >> 5, qb = id & 31, b = bh >> 2, h = bh & 3;
        att_issue(sv, KV + (size_t)(b * MEML) * 2048 + h * 256, F.tid);
        const size_t qrow = (size_t)b * SEQ + qb * 128 + 16 * w + fr;
#pragma unroll
        for (int ks = 0; ks < 8; ++ks) qf[ks] = *(const bf16x8*)(Q + qrow * D + h * 256 + 32 * ks + 8 * fq); }
    for (; id < NUNITS; id += F.G) {
        const int bh = id >> 5, qb = id & 31, b = bh >> 2, h = bh & 3;
        const bf16_t* Vg = KV + (size_t)(b * MEML) * 2048 + h * 256 + 1024;
        const size_t qrow = (size_t)b * SEQ + qb * 128 + 16 * w + fr;
        att_write(F.lds, sv, F.tid);
        __syncthreads();
        att_issue(sv, Vg, F.tid);
        f32x4 st[16];
        const LAS unsigned char* kbase = F.lds + fr * KS_B + fq * 16;
#pragma unroll
        for (int kt = 0; kt < 16; kt += 2) { st[kt] = (f32x4){0.f, 0.f, 0.f, 0.f}; st[kt + 1] = (f32x4){0.f, 0.f, 0.f, 0.f};
            const LAS unsigned char* kb0 = kbase + kt * 16 * KS_B; const LAS unsigned char* kb1 = kb0 + 16 * KS_B;
#pragma unroll
            for (int ks = 0; ks < 8; ++ks) { const bf16x8 k0 = *(const LAS bf16x8*)(kb0 + ks * 64), k1 = *(const LAS bf16x8*)(kb1 + ks * 64);
                st[kt] = __builtin_amdgcn_mfma_f32_16x16x32_bf16(k0, qf[ks], st[kt], 0, 0, 0); st[kt + 1] = __builtin_amdgcn_mfma_f32_16x16x32_bf16(k1, qf[ks], st[kt + 1], 0, 0, 0);
                if ((ks & 3) == 3) __builtin_amdgcn_sched_barrier(0); } }
        float mx = -3.0e38f;
#pragma unroll
        for (int kt = 0; kt < 16; ++kt) mx = fmaxf(mx, fmaxf(fmaxf(st[kt][0], st[kt][1]), fmaxf(st[kt][2], st[kt][3])));
        mx = fq_max(mx);
        float l = 0.f;
#pragma unroll
        for (int kt = 0; kt < 16; ++kt) {
#pragma unroll
            for (int i = 0; i < 4; ++i) { const float e = __builtin_amdgcn_exp2f(st[kt][i] - mx); st[kt][i] = e; l += e; } }
        l = fq_sum(l);
        bf16x8 pk[8];
#pragma unroll
        for (int kk = 0; kk < 8; ++kk) { u32x4 wv; wv.x = pk2(st[2 * kk][0], st[2 * kk][1]); wv.y = pk2(st[2 * kk][2], st[2 * kk][3]); wv.z = pk2(st[2 * kk + 1][0], st[2 * kk + 1][1]); wv.w = pk2(st[2 * kk + 1][2], st[2 * kk + 1][3]);
            pk[kk] = __builtin_bit_cast(bf16x8, wv); }
        __syncthreads();
        att_write(F.lds, sv, F.tid);
        __syncthreads();
        { const int nid = id + F.G;
          if (nid < NUNITS) { const int nbh = nid >> 5, nqb = nid & 31, nb = nbh >> 2, nh = nbh & 3;
              att_issue(sv, KV + (size_t)(nb * MEML) * 2048 + nh * 256, F.tid);
              const size_t nqrow = (size_t)nb * SEQ + nqb * 128 + 16 * w + fr;
#pragma unroll
              for (int ks = 0; ks < 8; ++ks) qf[ks] = *(const bf16x8*)(Q + nqrow * D + nh * 256 + 32 * ks + 8 * fq); } }
        const float inv = 1.0f / l;
        bf16_t* op = O + qrow * D + h * 256 + 4 * fq;
        const LAS unsigned char* vbase = F.lds + (4 * fq + q4) * KS_B + 8 * p4;
#pragma unroll
        for (int dt = 0; dt < 16; dt += 2) { f32x4 o0 = (f32x4){0.f, 0.f, 0.f, 0.f}, o1 = (f32x4){0.f, 0.f, 0.f, 0.f};
#pragma unroll
            for (int kk = 0; kk < 8; ++kk) {
                const LAS unsigned char* vb = vbase + kk * 32 * KS_B + dt * 32;
                const s16x4 lo0 = tr_read(vb), hi0 = tr_read(vb + 16 * KS_B), lo1 = tr_read(vb + 32), hi1 = tr_read(vb + 16 * KS_B + 32);
                const bf16x8 v0 = (bf16x8){lo0[0], lo0[1], lo0[2], lo0[3], hi0[0], hi0[1], hi0[2], hi0[3]}, v1 = (bf16x8){lo1[0], lo1[1], lo1[2], lo1[3], hi1[0], hi1[1], hi1[2], hi1[3]};
                o0 = __builtin_amdgcn_mfma_f32_16x16x32_bf16(v0, pk[kk], o0, 0, 0, 0); o1 = __builtin_amdgcn_mfma_f32_16x16x32_bf16(v1, pk[kk], o1, 0, 0, 0); }
            u32x2 w0; w0.x = pk2(o0[0] * inv, o0[1] * inv); w0.y = pk2(o0[2] * inv, o0[3] * inv); *(u32x2*)(op + 16 * dt) = w0;
            u32x2 w1; w1.x = pk2(o1[0] * inv, o1[1] * inv); w1.y = pk2(o1[2] * inv, o1[3] * inv); *(u32x2*)(op + 16 * dt + 16) = w1; }
        __syncthreads();
    }
}

__device__ __forceinline__ void p9_final(Frame& F, float* dst) {
    const int gw = F.bid * NWAVES + F.wave, NGW = F.G * NWAVES; const float* ps = (const float*)(F.ws + WS_PS3); const bf16_t* XB = (const bf16_t*)(F.ws + WS_XB);
    f32x4 g[4];
#pragma unroll
    for (int j = 0; j < 4; ++j) g[j] = *(const f32x4*)(F.in[I_LN_FINAL_G] + (j >> 1) * 512 + 8 * F.lane + (j & 1) * 4);
    for (int m0 = gw; m0 < M; m0 += 4 * NGW) { u32x4 v[4][2]; float rs[4];
#pragma unroll
        for (int r = 0; r < 4; ++r) { const int m = m0 + r * NGW; rs[r] = rstd_from_ps(ps, m); v[r][0] = *(const u32x4*)(XB + (size_t)m * D + 8 * F.lane); v[r][1] = *(const u32x4*)(XB + (size_t)m * D + 512 + 8 * F.lane); }
#pragma unroll
        for (int r = 0; r < 4; ++r) { const int m = m0 + r * NGW;
#pragma unroll
            for (int hh = 0; hh < 2; ++hh) { float f[8]; unpack8(v[r][hh], f); f32x4 a, b;
#pragma unroll
                for (int i = 0; i < 4; ++i) { a[i] = f[i] * rs[r] * g[2 * hh][i]; b[i] = f[4 + i] * rs[r] * g[2 * hh + 1][i]; }
                f32x4* o = (f32x4*)(dst + (size_t)m * D + hh * 512 + 8 * F.lane); o[0] = a; o[1] = b; } } }
}

template <class Epi>
__global__ __launch_bounds__(256) void gemm_naive(const bf16_t* A, const bf16_t* Bt, Epi epi, int K, int pad_) {
    const int wave = threadIdx.x >> 6, lane = threadIdx.x & 63, fr = lane & 15, fq = lane >> 4;
    const int row0 = blockIdx.y * 64 + (wave >> 1) * 32, col0 = blockIdx.x * 64 + (wave & 1) * 32;
    f32x4 acc[2][2];
    for (int i = 0; i < 2; ++i) for (int j = 0; j < 2; ++j) acc[i][j] = (f32x4){0.f, 0.f, 0.f, 0.f};
    for (int k0 = 0; k0 < K; k0 += 32) { bf16x8 a[2], b[2];
        for (int i = 0; i < 2; ++i) a[i] = *(const bf16x8*)(A + (size_t)(row0 + 16 * i + fr) * K + k0 + 8 * fq);
        for (int j = 0; j < 2; ++j) b[j] = *(const bf16x8*)(Bt + (size_t)(col0 + 16 * j + fr) * K + k0 + 8 * fq);
        for (int i = 0; i < 2; ++i) for (int j = 0; j < 2; ++j) acc[i][j] = __builtin_amdgcn_mfma_f32_16x16x32_bf16(a[i], b[j], acc[i][j], 0, 0, 0); }
    for (int i = 0; i < 2; ++i) for (int j = 0; j < 2; ++j) for (int r = 0; r < 4; ++r) epi(row0 + 16 * i + 4 * fq + r, col0 + 16 * j + fr, acc[i][j][r]);
}
struct NEpiAct { bf16_t* O; int ldc; int gelu_cols; __device__ void operator()(int r, int c, float v) const { if (c < gelu_cols) v = gelu_tanh(v); O[(size_t)r * ldc + c] = (bf16_t)f2bf(v); } };
struct NEpiRes { const float* base; float* out; bf16_t* xb; __device__ void operator()(int r, int c, float v) const { const float o = base[(size_t)r * D + c] + v; out[(size_t)r * D + c] = o; if (xb) xb[(size_t)r * D + c] = (bf16_t)f2bf(o); } };
struct NEpiRowScale { bf16_t* O; const float* ps; int ldc; float scale; __device__ void operator()(int r, int c, float v) const { O[(size_t)r * ldc + c] = (bf16_t)f2bf(v * rstd_from_ps(ps, r) * scale); } };
struct NEpiGUraw { float* T; __device__ void operator()(int r, int c, float v) const { T[(size_t)r * 256 + c] = v; } };
__global__ __launch_bounds__(256) void naive_rowsumsq(const float* R, float* ps) {
    const int row = blockIdx.x * 4 + (threadIdx.x >> 6), lane = threadIdx.x & 63; float s = 0.f;
    for (int j = 0; j < 4; ++j) { const f32x4 v = ((const f32x4*)(R + (size_t)row * D))[64 * j + lane]; s += (v[0] * v[0] + v[1] * v[1]) + (v[2] * v[2] + v[3] * v[3]); }
    s = wave_sum(s); if (lane < 16) ps[(size_t)row * 16 + lane] = lane == 0 ? s : 0.f;
}
__global__ __launch_bounds__(256) void naive_gu(const bf16_t* A, const bf16_t* Wgu_t, const float* ps, bf16_t* HF) {
    const int wave = threadIdx.x >> 6, lane = threadIdx.x & 63, fr = lane & 15, fq = lane >> 4;
    const int row0 = blockIdx.y * 64 + (wave >> 1) * 32, hc0 = blockIdx.x * 32 + (wave & 1) * 16;
    const int tile = hc0 >> 7, j = hc0 & 127; const int brow_g = 256 * tile + j, brow_u = brow_g + 128;
    f32x4 ag[2], au[2];
    for (int i = 0; i < 2; ++i) { ag[i] = (f32x4){0.f, 0.f, 0.f, 0.f}; au[i] = ag[i]; }
    for (int k0 = 0; k0 < D; k0 += 32) { bf16x8 a[2];
        for (int i = 0; i < 2; ++i) a[i] = *(const bf16x8*)(A + (size_t)(row0 + 16 * i + fr) * D + k0 + 8 * fq);
        const bf16x8 bg = *(const bf16x8*)(Wgu_t + (size_t)(brow_g + fr) * D + k0 + 8 * fq), bu = *(const bf16x8*)(Wgu_t + (size_t)(brow_u + fr) * D + k0 + 8 * fq);
        for (int i = 0; i < 2; ++i) { ag[i] = __builtin_amdgcn_mfma_f32_16x16x32_bf16(a[i], bg, ag[i], 0, 0, 0); au[i] = __builtin_amdgcn_mfma_f32_16x16x32_bf16(a[i], bu, au[i], 0, 0, 0); } }
    for (int i = 0; i < 2; ++i) for (int r = 0; r < 4; ++r) { const int row = row0 + 16 * i + 4 * fq + r; const float rs = rstd_from_ps(ps, row);
        HF[(size_t)row * DFF + hc0 + fr] = (bf16_t)f2bf(silu(ag[i][r] * rs) * (au[i][r] * rs)); }
}


constexpr int CW_BAR = 4096;
constexpr size_t CTL_ZERO_BYTES = 64 * 1024;
constexpr int MISC_OFF = 147456;
#define XB_TMO      128
#define XB_XCNT(j)  (256  + 64 * (j))
#define XB_XSUB(j)  (1280 + 64 * (j))
#define XB_XGEN(j)  (2304 + 64 * (j))
#define XB_TOP      3328
#define XB_TOPGEN   3392
#define XCD_BAR_WORDS 3456
#define XB_SPIN_CAP (1u << 18)
__device__ __forceinline__ unsigned xb_ld(unsigned* p)              { return __hip_atomic_load(p, __ATOMIC_RELAXED, __HIP_MEMORY_SCOPE_AGENT); }
__device__ __forceinline__ unsigned xb_add(unsigned* p, unsigned v) { return __hip_atomic_fetch_add(p, v, __ATOMIC_RELAXED, __HIP_MEMORY_SCOPE_AGENT); }
__device__ __forceinline__ unsigned xb_xcc_id() { return (unsigned)__builtin_amdgcn_s_getreg((3 << 11) | 20) & 0xFu; }
#define XB_SPIN(cond, bar) do { unsigned _sp = 0; while (cond) { __builtin_amdgcn_s_sleep(1); \
    if ((++_sp & 255u) == 0u) { if (xb_ld(&(bar)[XB_TMO])) break; if (_sp > XB_SPIN_CAP) { atomicAdd(&(bar)[XB_TMO], 1u); break; } } } } while (0)
struct XcdBarrier { unsigned* bar; unsigned x; volatile LAS unsigned* st; };
__device__ __forceinline__ XcdBarrier xcd_barrier_post(unsigned* bar, volatile LAS unsigned* st, int wave) {
    XcdBarrier b; b.bar = bar; b.x = xb_xcc_id(); b.st = st;
    if (wave == 0 && lane_id() == 0) (void)xb_add(&bar[XB_XCNT(b.x)], 1u);
    return b;
}
__device__ __forceinline__ void xcd_barrier_complete(unsigned* bar, unsigned x, unsigned& nloc, unsigned& nx) {
    const unsigned G = gridDim.x * gridDim.y * gridDim.z;
    unsigned sum, cnt, mine, sp = 0u;
    for (;;) {
        sum = 0u; cnt = 0u; mine = 0u;
#pragma unroll
        for (unsigned j = 0; j < 16; ++j) { const unsigned c = xb_ld(&bar[XB_XCNT(j)]); sum += c; cnt += (c > 0u) ? 1u : 0u; mine = (j == x) ? c : mine; }
        if (sum == G) break;
        __builtin_amdgcn_s_sleep(1);
        if ((++sp & 255u) == 0u) { if (xb_ld(&bar[XB_TMO])) break; if (sp > XB_SPIN_CAP) { atomicAdd(&bar[XB_TMO], 1u); break; } }
    }
    nloc = mine > 0u ? mine : 1u; nx = cnt > 0u ? cnt : 1u;
}
__device__ __forceinline__ void xcd_barrier(const XcdBarrier& b, int wave) {
    asm volatile("s_waitcnt vmcnt(0)" ::: "memory");
    __syncthreads();
    if (wave == 0 && lane_id() == 0) {
        unsigned* bar = b.bar;
        __builtin_amdgcn_s_waitcnt(0);
        unsigned nloc = b.st[0], nx = b.st[1];
        if (nloc == 0u) { xcd_barrier_complete(bar, b.x, nloc, nx); b.st[0] = nloc; b.st[1] = nx; }
        const unsigned old = xb_add(&bar[XB_XSUB(b.x)], 1u);
        const unsigned gen = old / nloc;
        if (old + 1u == (gen + 1u) * nloc) {
            __builtin_amdgcn_fence(__ATOMIC_RELEASE, "agent");
            asm volatile("s_waitcnt vmcnt(0)" ::: "memory");
            const unsigned og = xb_add(&bar[XB_TOP], 1u);
            const unsigned tg = og / nx;
            if (og + 1u == (tg + 1u) * nx) xb_add(&bar[XB_TOPGEN], 1u);
            else XB_SPIN(xb_ld(&bar[XB_TOPGEN]) == tg, bar);
            __builtin_amdgcn_fence(__ATOMIC_ACQUIRE, "agent");
            xb_add(&bar[XB_XGEN(b.x)], 1u);
            asm volatile("s_waitcnt vmcnt(0)" ::: "memory");
        } else {
            XB_SPIN(xb_ld(&bar[XB_XGEN(b.x)]) == gen, bar);
            __builtin_amdgcn_fence(__ATOMIC_ACQUIRE, "agent");
            asm volatile("s_waitcnt vmcnt(0)" ::: "memory");
        }
    }
    __syncthreads();
}

__device__ __forceinline__ void make_frame(Frame& F, const Params& p, unsigned char* lds) {
    F.lds = (LAS unsigned char*)lds; F.wave = wave_id(); F.lane = lane_id(); F.tid = F.wave * 64 + F.lane; F.G = gridDim.x; F.bid = blockIdx.x;
    F.in = p.in; F.out = p.out; F.ws = p.ws;
}
#define GEMM_PHASE(EpiT, Aptr, Bptr, Mv, Nv, Kv, ...) do { pg8::Gemm g_{(const bf16_t*)(Aptr), (const bf16_t*)(Bptr), Mv, Nv, Kv}; pg8::StaticOrder S_; S_.init(Mv, Nv, F.G, F.bid); \
    pg8::EpiT E_{__VA_ARGS__}; pg8::gemm_phase<pg8::EpiT, pg8::StaticOrder, true, true>(F.lds, g_, S_, E_, F.wave); } while (0)

template <int PH>
__device__ __forceinline__ void run_phase(Frame& F) {
    unsigned char* ws = F.ws;
    { int l = lane_id(); asm volatile("" : "+v"(l)); l &= 63; F.lane = l; F.tid = (F.wave & 7) * 64 + l; }
    if constexpr (PH == 0) p0_prologue(F);
    if constexpr (PH == 1) {
        GEMM_PHASE(EpiAct, ws + WS_MEMN, ws + WS_WKV, MROWS, 2 * D, D, (bf16_t*)(ws + WS_KV), 2 * D, 0);
        GEMM_PHASE(EpiAct, ws + WS_XB, ws + WS_WIN, M, NIN, D, (bf16_t*)(ws + WS_H), NIN, 1024);
    }
    if constexpr (PH == 2) p2_sgu_conv(F);
    if constexpr (PH == 3) GEMM_PHASE(EpiRes, ws + WS_Y, ws + WS_WOUT, M, D, D, (const bf16_t*)(ws + WS_XB), (bf16_t*)(ws + WS_XB), (float*)(ws + WS_PS1), (const float*)(ws + WS_RX));
    if constexpr (PH == 4) GEMM_PHASE(EpiRowScale, ws + WS_XB, ws + WS_WQ, M, D, D, (bf16_t*)(ws + WS_Q), D, (const float*)(ws + WS_PS1), QSCALE);
    if constexpr (PH == 5) p5_attention(F);
    if constexpr (PH == 6) GEMM_PHASE(EpiRes, ws + WS_O, ws + WS_WO, M, D, D, (const bf16_t*)(ws + WS_XB), (bf16_t*)(ws + WS_XB), (float*)(ws + WS_PS2), (const float*)nullptr);
    if constexpr (PH == 7) GEMM_PHASE(EpiGU, ws + WS_XB, ws + WS_WGU, M, NGU, D, (bf16_t*)(ws + WS_HF), (const float*)(ws + WS_PS2));
    if constexpr (PH == 8) GEMM_PHASE(EpiRes, ws + WS_HF, ws + WS_WDN, M, D, DFF, (const bf16_t*)(ws + WS_XB), (bf16_t*)(ws + WS_XB), (float*)(ws + WS_PS3), (const float*)nullptr);
    if constexpr (PH == 9) p9_final(F, F.out);
    if constexpr (PH == 19) p9_final(F, (float*)(ws + WS_H));
}

template <int PH>
__global__ void __launch_bounds__(NTHREADS, 2) phase_kernel(Params p) {
    extern __shared__ __attribute__((aligned(16))) unsigned char lds[];
    Frame F; make_frame(F, p, lds);
    run_phase<PH>(F);
}

__global__ void __launch_bounds__(NTHREADS, 2) mega_kernel(Params p) {
    extern __shared__ __attribute__((aligned(16))) unsigned char lds[];
    Frame F; make_frame(F, p, lds);
    volatile LAS unsigned* MISC = (volatile LAS unsigned*)(F.lds + MISC_OFF);
    if (F.tid < 32) MISC[F.tid] = 0u;
    __syncthreads();
    const XcdBarrier bar = xcd_barrier_post((unsigned*)(p.ws + WS_CTL) + CW_BAR, MISC + 8, F.wave);
#define GRID_BAR() xcd_barrier(bar, F.wave)
#define PROBE2(bit, ph) do { if (MK_PROBE & (1 << (bit))) { run_phase<ph>(F); GRID_BAR(); } } while (0)
    PROBE2(0, 0); run_phase<0>(F); GRID_BAR();
    PROBE2(1, 1); run_phase<1>(F); GRID_BAR();
    PROBE2(2, 2); run_phase<2>(F); GRID_BAR();
    PROBE2(3, 3); run_phase<3>(F); GRID_BAR();
    PROBE2(4, 4); run_phase<4>(F); GRID_BAR();
    PROBE2(5, 5); run_phase<5>(F); GRID_BAR();
    run_phase<6>(F); GRID_BAR();
    PROBE2(7, 7); run_phase<7>(F); GRID_BAR();
    run_phase<8>(F); GRID_BAR();
    PROBE2(9, 19); run_phase<9>(F);
#undef GRID_BAR
}

template <int PH> static void launch_phase(const Params& p, int grid, hipStream_t stream) {
    static bool attr = false;
    if (!attr) { (void)hipFuncSetAttribute((const void*)phase_kernel<PH>, hipFuncAttributeMaxDynamicSharedMemorySize, LDS_BYTES); attr = true; }
    hipLaunchKernelGGL(phase_kernel<PH>, dim3(grid), dim3(NTHREADS), LDS_BYTES, stream, p);
}

extern "C" void kernel_launch(void* const* d_in, const int* in_sizes, int n_in, void* d_out, int out_size, void* d_ws, size_t ws_size, hipStream_t stream) {
    static int grid = 0;
    if (grid == 0) {
        if (n_in != 21 || in_sizes[0] != M * D || out_size != M * D || ws_size < WS_END) { fprintf(stderr, "kernel_launch: unexpected shapes (n_in %d, in0 %d, out %d, ws %zu)\n", n_in, n_in > 0 ? in_sizes[0] : -1, out_size, ws_size); grid = -1; return; }
        int dev = 0, cus = 0, per_cu = 0;
        (void)hipGetDevice(&dev); (void)hipDeviceGetAttribute(&cus, hipDeviceAttributeMultiprocessorCount, dev);
        (void)hipFuncSetAttribute((const void*)mega_kernel, hipFuncAttributeMaxDynamicSharedMemorySize, LDS_BYTES);
        (void)hipOccupancyMaxActiveBlocksPerMultiprocessor(&per_cu, (const void*)mega_kernel, NTHREADS, LDS_BYTES);
        if (per_cu < 1) { fprintf(stderr, "kernel_launch: occupancy query says %d blocks per CU\n", per_cu); per_cu = 1; }
        (void)hipGetLastError();
        grid = cus * 1;
    }
    if (grid < 0) return;
    Params p{};
    for (int i = 0; i < 21; ++i) p.in[i] = (const float*)d_in[i];
    p.out = (float*)d_out; p.ws = (unsigned char*)d_ws; p.ph_lo = 0; p.ph_hi = 10;
    unsigned char* ws = (unsigned char*)d_ws;
#if MK_MODE == 2
    (void)hipMemsetAsync(ws + WS_CTL, 0, CTL_ZERO_BYTES, stream);
    void* args[] = {&p};
    hipError_t e = hipLaunchCooperativeKernel((const void*)mega_kernel, dim3(grid), dim3(NTHREADS), args, LDS_BYTES, stream);
    if (e != hipSuccess) fprintf(stderr, "cooperative launch failed: %s (grid %d)\n", hipGetErrorString(e), grid);
#elif MK_MODE == 1
    launch_phase<0>(p, grid, stream); launch_phase<1>(p, grid, stream); launch_phase<2>(p, grid, stream); launch_phase<3>(p, grid, stream); launch_phase<4>(p, grid, stream);
    launch_phase<5>(p, grid, stream); launch_phase<6>(p, grid, stream); launch_phase<7>(p, grid, stream); launch_phase<8>(p, grid, stream); launch_phase<9>(p, grid, stream);
#else
    launch_phase<0>(p, grid, stream);
    { NEpiAct e{(bf16_t*)(ws + WS_KV), 2 * D, 0}; hipLaunchKernelGGL(gemm_naive<NEpiAct>, dim3(2 * D / 64, MROWS / 64), dim3(256), 0, stream, (const bf16_t*)(ws + WS_MEMN), (const bf16_t*)(ws + WS_WKV), e, D, 0); }
    { NEpiAct e{(bf16_t*)(ws + WS_H), NIN, 1024}; hipLaunchKernelGGL(gemm_naive<NEpiAct>, dim3(NIN / 64, M / 64), dim3(256), 0, stream, (const bf16_t*)(ws + WS_XB), (const bf16_t*)(ws + WS_WIN), e, D, 0); }
    launch_phase<2>(p, grid, stream);
    { NEpiRes e{(const float*)d_in[I_X], (float*)d_out, (bf16_t*)(ws + WS_XB)}; hipLaunchKernelGGL(gemm_naive<NEpiRes>, dim3(D / 64, M / 64), dim3(256), 0, stream, (const bf16_t*)(ws + WS_Y), (const bf16_t*)(ws + WS_WOUT), e, D, 0); }
    hipLaunchKernelGGL(naive_rowsumsq, dim3(M / 4), dim3(256), 0, stream, (const float*)d_out, (float*)(ws + WS_PS1));
    { NEpiRowScale e{(bf16_t*)(ws + WS_Q), (const float*)(ws + WS_PS1), D, QSCALE}; hipLaunchKernelGGL(gemm_naive<NEpiRowScale>, dim3(D / 64, M / 64), dim3(256), 0, stream, (const bf16_t*)(ws + WS_XB), (const bf16_t*)(ws + WS_WQ), e, D, 0); }
    launch_phase<5>(p, grid, stream);
    { NEpiRes e{(const float*)d_out, (float*)d_out, (bf16_t*)(ws + WS_XB)}; hipLaunchKernelGGL(gemm_naive<NEpiRes>, dim3(D / 64, M / 64), dim3(256), 0, stream, (const bf16_t*)(ws + WS_O), (const bf16_t*)(ws + WS_WO), e, D, 0); }
    hipLaunchKernelGGL(naive_rowsumsq, dim3(M / 4), dim3(256), 0, stream, (const float*)d_out, (float*)(ws + WS_PS2));
    hipLaunchKernelGGL(naive_gu, dim3(DFF / 32, M / 64), dim3(256), 0, stream, (const bf16_t*)(ws + WS_XB), (const bf16_t*)(ws + WS_WGU), (const float*)(ws + WS_PS2), (bf16_t*)(ws + WS_HF));
    { NEpiRes e{(const float*)d_out, (float*)d_out, (bf16_t*)nullptr}; hipLaunchKernelGGL(gemm_naive<NEpiRes>, dim3(D / 64, M / 64), dim3(256), 0, stream, (const bf16_t*)(ws + WS_HF), (const bf16_t*)(ws + WS_WDN), e, DFF, 0); }
    hipLaunchKernelGGL(naive_rowsumsq, dim3(M / 4), dim3(256), 0, stream, (const float*)d_out, (float*)(ws + WS_PS3));
    launch_phase<9>(p, grid, stream);
#endif
}
```

```cpp
#include <hip/hip_runtime.h>
#include <hip/hip_cooperative_groups.h>
#include <cstdio>
#include <cstdint>
namespace cg = cooperative_groups;

#ifndef MK_PROBE
#define MK_PROBE 0
#endif
#ifndef MK_MODE
#define MK_MODE 2
#endif

constexpr int D = 1024, BATCH = 8, SEQ = 4096, M = BATCH * SEQ;
constexpr int MEML = 256, MROWS = BATCH * MEML;
constexpr int NIN = 2560, DFF = 2816, NGU = 2 * DFF;
constexpr int CHUNK = 128, NCHUNK = M / CHUNK;
constexpr float EPS = 1e-6f;
constexpr float QSCALE = 0.0625f * 1.4426950408889634f;

typedef unsigned short bf16_t;
typedef short bf16x8 __attribute__((ext_vector_type(8)));
typedef float f32x4 __attribute__((ext_vector_type(4)));
typedef float f32x2 __attribute__((ext_vector_type(2)));
typedef unsigned u32x4 __attribute__((ext_vector_type(4)));
typedef unsigned u32x2 __attribute__((ext_vector_type(2)));
typedef short s16x4 __attribute__((ext_vector_type(4)));
#define LAS __attribute__((address_space(3)))

constexpr size_t MiB = 1u << 20;
constexpr size_t WS_CTL = 0;
constexpr size_t WS_WIN = 2 * MiB, WS_WOUT = 7 * MiB, WS_WQ = 9 * MiB, WS_WKV = 11 * MiB, WS_WO = 15 * MiB, WS_WGU = 17 * MiB, WS_WDN = 28 * MiB;
constexpr size_t WS_WM = 34 * MiB, WS_MEMN = 35 * MiB, WS_KV = 39 * MiB;
constexpr size_t WS_PS1 = 48 * MiB, WS_PS2 = 50 * MiB, WS_PS3 = 52 * MiB, WS_RX = 54 * MiB;
constexpr size_t WS_XB = 64 * MiB, WS_H = 128 * MiB, WS_Y = 288 * MiB, WS_Q = 352 * MiB, WS_O = 416 * MiB, WS_HF = 128 * MiB, WS_END = 480 * MiB;

struct Params {
    const float* in[21];
    float* out;
    unsigned char* ws;
    int ph_lo, ph_hi;
};

__device__ __forceinline__ int lane_id() { unsigned l; asm volatile("v_mbcnt_lo_u32_b32 %0, -1, 0\n\tv_mbcnt_hi_u32_b32 %0, -1, %0" : "=v"(l)); return (int)(l & 63u); }
__device__ __forceinline__ int wave_id() { return __builtin_amdgcn_readfirstlane((int)threadIdx.x >> 6) & 7; }
__device__ __forceinline__ float xor16_add(float v) { const unsigned u = __builtin_bit_cast(unsigned, v); auto r = __builtin_amdgcn_permlane16_swap(u, u, false, false); return __builtin_bit_cast(float, (unsigned)r[0]) + __builtin_bit_cast(float, (unsigned)r[1]); }
__device__ __forceinline__ float xor32_add(float v) { const unsigned u = __builtin_bit_cast(unsigned, v); auto r = __builtin_amdgcn_permlane32_swap(u, u, false, false); return __builtin_bit_cast(float, (unsigned)r[0]) + __builtin_bit_cast(float, (unsigned)r[1]); }
__device__ __forceinline__ float xor16_max(float v) { const unsigned u = __builtin_bit_cast(unsigned, v); auto r = __builtin_amdgcn_permlane16_swap(u, u, false, false); return fmaxf(__builtin_bit_cast(float, (unsigned)r[0]), __builtin_bit_cast(float, (unsigned)r[1])); }
__device__ __forceinline__ float xor32_max(float v) { const unsigned u = __builtin_bit_cast(unsigned, v); auto r = __builtin_amdgcn_permlane32_swap(u, u, false, false); return fmaxf(__builtin_bit_cast(float, (unsigned)r[0]), __builtin_bit_cast(float, (unsigned)r[1])); }
__device__ __forceinline__ float fq_sum(float v) { return xor32_add(xor16_add(v)); }
__device__ __forceinline__ float fq_max(float v) { return xor32_max(xor16_max(v)); }
template <int CTRL> __device__ __forceinline__ float dpp_f(float v) { return __builtin_bit_cast(float, __builtin_amdgcn_update_dpp(0, __builtin_bit_cast(int, v), CTRL, 0xf, 0xf, true)); }
__device__ __forceinline__ float wave_sum(float v) {
    v += dpp_f<0xB1>(v);
    v += dpp_f<0x4E>(v);
    v += dpp_f<0x141>(v);
    v += dpp_f<0x140>(v);
    return fq_sum(v);
}
__device__ __forceinline__ unsigned f2bf(float f) { unsigned u = __builtin_bit_cast(unsigned, f); return (u + 0x7fffu + ((u >> 16) & 1u)) >> 16; }
__device__ __forceinline__ unsigned pk2(float lo, float hi) { return f2bf(lo) | (f2bf(hi) << 16); }
__device__ __forceinline__ float bf_lo(unsigned w) { return __builtin_bit_cast(float, w << 16); }
__device__ __forceinline__ float bf_hi(unsigned w) { return __builtin_bit_cast(float, w & 0xffff0000u); }
__device__ __forceinline__ float bf2f(bf16_t h) { return __builtin_bit_cast(float, (unsigned)h << 16); }
__device__ __forceinline__ float gelu_tanh(float a) {
    const float t = a * a * (-2.302208198f * 0.044715f) + (-2.302208198f);
    return a * __builtin_amdgcn_rcpf(1.0f + __builtin_amdgcn_exp2f(a * t));
}
__device__ __forceinline__ float silu(float g) { return g * __builtin_amdgcn_rcpf(1.0f + __builtin_amdgcn_exp2f(-1.4426950408889634f * g)); }
__device__ __forceinline__ float rstd_from_ps(const float* ps, int row) {
    const f32x4* p = (const f32x4*)(ps + (size_t)row * 16);
    const f32x4 a = p[0], b = p[1], c = p[2], d = p[3];
    const float s = ((a[0] + a[1]) + (a[2] + a[3])) + ((b[0] + b[1]) + (b[2] + b[3])) + ((c[0] + c[1]) + (c[2] + c[3])) + ((d[0] + d[1]) + (d[2] + d[3]));
    return __builtin_amdgcn_rsqf(s * (1.0f / D) + EPS);
}

namespace pg8 {
#define PG8_LAS __attribute__((address_space(3)))
constexpr int BM = 256, BK = 64, HALF = 128, HTB = HALF * BK * 2, STAGE_BYTES = 8 * HTB, NXCD = 8, WGM = 8;
__host__ __device__ __forceinline__ int lds_byte(int r, int c) { const int st = (r >> 4) * 2 + (c >> 5), rr = r & 15, cc = c & 31, ob = rr * 64 + cc * 2; return st * 1024 + (ob ^ (((ob >> 9) & 1) << 5)); }
__host__ __device__ __forceinline__ void stage_rc(int b, int& R, int& C) { const int st = b / 1024, sb = b % 1024, swz = sb ^ (((sb >> 9) & 1) << 5); R = (st >> 1) * 16 + swz / 64; C = (st & 1) * 32 + (swz % 64) / 2; }
__host__ __device__ __forceinline__ int perm32(int rho) { const int n = rho >> 4, i = rho & 15; return 8 * (i >> 2) + 4 * n + (i & 3); }

struct Unit { int pm, pn; };
struct Gemm { const bf16_t* A; const bf16_t* Bt; int M, N, K; };

struct StaticOrder {
    int nM, nN, nwg, G, c;
    __host__ __device__ void init(int M_, int N_, int G_, int c_) { nM = M_ / BM; nN = N_ / BM; nwg = nM * nN; G = G_; c = c_; }
    __host__ __device__ bool next(int i, Unit& u) const {
        const long L = (long)i * G + c; if (L >= nwg) return false;
        int wgid = (int)L; { const int q = nwg / NXCD, r = nwg % NXCD, xcd = wgid % NXCD, off = wgid / NXCD; wgid = (xcd < r ? xcd * (q + 1) : r * (q + 1) + (xcd - r) * q) + off; }
        const int nig = WGM * nN, gid = wgid / nig, fm = gid * WGM, gsz = (nM - fm) < WGM ? (nM - fm) : WGM;
        u.pm = fm + ((wgid % nig) % gsz); u.pn = (wgid % nig) / gsz; return true;
    }
    __device__ __forceinline__ void a_ready(const Unit&) const {}
    __device__ __forceinline__ void done(const Unit&) const {}
};

typedef __bf16 bf16x2_t __attribute__((ext_vector_type(2)));
__device__ __forceinline__ unsigned cvt_pk_bf16(float lo, float hi) { f32x2 v = {lo, hi}; bf16x2_t b = __builtin_convertvector(v, bf16x2_t); return __builtin_bit_cast(unsigned, b); }

struct EpiAct {
    static constexpr bool PERM = true, AFTER_DRAIN = false;
    bf16_t* O; int ldc; int gelu_cols;
    __device__ __forceinline__ void unit_begin(const Unit&, PG8_LAS unsigned char*, int, int) const {}
    __device__ __forceinline__ void operator()(const f32x4 (&acc)[2][2][4][2], const Unit& u, int, PG8_LAS unsigned char*, int wr, int wc, int fr, int fq) const {
        const int row0 = u.pm * BM + wr * 64 + fr, col0 = u.pn * BM + wc * 32 + 8 * fq;
        const bool act = (u.pn * BM) < gelu_cols;
#pragma unroll
        for (int ai = 0; ai < 2; ++ai)
#pragma unroll
            for (int m = 0; m < 4; ++m) { bf16_t* rowp = O + (size_t)(row0 + ai * HALF + m * 16) * ldc + col0;
#pragma unroll
                for (int bj = 0; bj < 2; ++bj) { f32x4 v0 = acc[ai][bj][m][0], v1 = acc[ai][bj][m][1];
                    if (act) {
#pragma unroll
                        for (int i = 0; i < 4; ++i) { v0[i] = gelu_tanh(v0[i]); v1[i] = gelu_tanh(v1[i]); } }
                    u32x4 w; w.x = cvt_pk_bf16(v0[0], v0[1]); w.y = cvt_pk_bf16(v0[2], v0[3]); w.z = cvt_pk_bf16(v1[0], v1[1]); w.w = cvt_pk_bf16(v1[2], v1[3]);
                    *(u32x4*)(rowp + bj * HALF) = w; } }
    }
};
__device__ __forceinline__ void rs_dma(const float* ps, const Unit& u, PG8_LAS unsigned char* lds, int wid, int lane) {
    if (wid >= 4) {
#pragma unroll
        for (int i = 0; i < 4; ++i) { const int L0 = ((wid - 4) * 4 + i) * 1024;
            __builtin_amdgcn_global_load_lds((const unsigned*)((const char*)ps + (size_t)u.pm * 16384 + L0 + lane * 16), (PG8_LAS unsigned*)(lds + STAGE_BYTES + L0), 16, 0, 0); } }
}
constexpr int RS2_OFF = STAGE_BYTES + 16384;
__device__ __forceinline__ void rs_reduce(PG8_LAS unsigned char* lds, int tid) {
    if (tid < 256) { const PG8_LAS f32x4* p = (const PG8_LAS f32x4*)(lds + STAGE_BYTES + tid * 64);
        const f32x4 a = p[0], b = p[1], c = p[2], d = p[3];
        const float s = ((a[0] + a[1]) + (a[2] + a[3])) + ((b[0] + b[1]) + (b[2] + b[3])) + ((c[0] + c[1]) + (c[2] + c[3])) + ((d[0] + d[1]) + (d[2] + d[3]));
        ((PG8_LAS float*)(lds + RS2_OFF))[tid] = __builtin_amdgcn_rsqf(s * (1.0f / D) + EPS); }
    asm volatile("s_waitcnt lgkmcnt(0)" ::: "memory"); __builtin_amdgcn_s_barrier(); asm volatile("" ::: "memory");
}
__device__ __forceinline__ float rs_get(PG8_LAS unsigned char* lds, int r) { return ((const PG8_LAS float*)(lds + RS2_OFF))[r]; }
struct EpiRowScale {
    static constexpr bool PERM = true, AFTER_DRAIN = false;
    bf16_t* O; int ldc; const float* ps; float scale;
    __device__ __forceinline__ void unit_begin(const Unit& u, PG8_LAS unsigned char* lds, int wid, int lane) const { rs_dma(ps, u, lds, wid, lane); }
    __device__ __forceinline__ void operator()(const f32x4 (&acc)[2][2][4][2], const Unit& u, int tid, PG8_LAS unsigned char* lds, int wr, int wc, int fr, int fq) const {
        const int row0 = u.pm * BM + wr * 64 + fr, col0 = u.pn * BM + wc * 32 + 8 * fq;
        rs_reduce(lds, tid);
        float rsv[2][4];
#pragma unroll
        for (int ai = 0; ai < 2; ++ai)
#pragma unroll
            for (int m = 0; m < 4; ++m) rsv[ai][m] = rs_get(lds, wr * 64 + fr + ai * HALF + m * 16) * scale;
#pragma unroll
        for (int ai = 0; ai < 2; ++ai)
#pragma unroll
            for (int m = 0; m < 4; ++m) { const int row = row0 + ai * HALF + m * 16; const float rs = rsv[ai][m];
                bf16_t* rowp = O + (size_t)row * ldc + col0;
#pragma unroll
                for (int bj = 0; bj < 2; ++bj) { const f32x4 v0 = acc[ai][bj][m][0] * rs, v1 = acc[ai][bj][m][1] * rs;
                    u32x4 w; w.x = cvt_pk_bf16(v0[0], v0[1]); w.y = cvt_pk_bf16(v0[2], v0[3]); w.z = cvt_pk_bf16(v1[0], v1[1]); w.w = cvt_pk_bf16(v1[2], v1[3]);
                    *(u32x4*)(rowp + bj * HALF) = w; } }
    }
};
struct EpiGU {
    static constexpr bool PERM = true, AFTER_DRAIN = false;
    bf16_t* O; const float* ps;
    __device__ __forceinline__ void unit_begin(const Unit& u, PG8_LAS unsigned char* lds, int wid, int lane) const { rs_dma(ps, u, lds, wid, lane); }
    __device__ __forceinline__ void operator()(const f32x4 (&acc)[2][2][4][2], const Unit& u, int tid, PG8_LAS unsigned char* lds, int wr, int wc, int fr, int fq) const {
        const int row0 = u.pm * BM + wr * 64 + fr, col0 = u.pn * HALF + wc * 32 + 8 * fq;
        rs_reduce(lds, tid);
        float rsv[2][4];
#pragma unroll
        for (int ai = 0; ai < 2; ++ai)
#pragma unroll
            for (int m = 0; m < 4; ++m) rsv[ai][m] = rs_get(lds, wr * 64 + fr + ai * HALF + m * 16);
#pragma unroll
        for (int ai = 0; ai < 2; ++ai)
#pragma unroll
            for (int m = 0; m < 4; ++m) { const int row = row0 + ai * HALF + m * 16; const float rs = rsv[ai][m];
                const float k1 = -1.4426950408889634f * rs, k2 = rs * rs;
                f32x4 h0, h1;
                { const f32x4 g0 = acc[ai][0][m][0], g1 = acc[ai][0][m][1], u0 = acc[ai][1][m][0], u1 = acc[ai][1][m][1];
                  const f32x4 p0 = (g0 * u0) * k2, p1 = (g1 * u1) * k2, e0 = g0 * k1, e1 = g1 * k1;
#pragma unroll
                  for (int i = 0; i < 4; ++i) { h0[i] = p0[i] * __builtin_amdgcn_rcpf(1.0f + __builtin_amdgcn_exp2f(e0[i])); h1[i] = p1[i] * __builtin_amdgcn_rcpf(1.0f + __builtin_amdgcn_exp2f(e1[i])); } }
                u32x4 w; w.x = cvt_pk_bf16(h0[0], h0[1]); w.y = cvt_pk_bf16(h0[2], h0[3]); w.z = cvt_pk_bf16(h1[0], h1[1]); w.w = cvt_pk_bf16(h1[2], h1[3]);
                *(u32x4*)(O + (size_t)row * DFF + col0) = w; }
    }
};
struct EpiRes {
    static constexpr bool PERM = true, AFTER_DRAIN = false;
    const bf16_t* base; bf16_t* xb; float* ps; const float* rowscale;
    __device__ __forceinline__ void unit_begin(const Unit&, PG8_LAS unsigned char*, int, int) const {}
    __device__ __forceinline__ void operator()(const f32x4 (&acc)[2][2][4][2], const Unit& u, int, PG8_LAS unsigned char*, int wr, int wc, int fr, int fq) const {
        const int row0 = u.pm * BM + wr * 64 + fr, col0 = u.pn * BM + wc * 32 + 8 * fq;
        u32x4 bv[4][2]; float sc[4];
#pragma unroll
        for (int m = 0; m < 4; ++m) { const int row = row0 + m * 16; sc[m] = rowscale ? rowscale[row] : 1.0f;
#pragma unroll
            for (int bj = 0; bj < 2; ++bj) bv[m][bj] = *(const u32x4*)(base + (size_t)row * D + col0 + bj * HALF); }
#pragma unroll
        for (int ai = 0; ai < 2; ++ai)
#pragma unroll
            for (int m = 0; m < 4; ++m) { const int row = row0 + ai * HALF + m * 16; float ss = 0.f; const float k = sc[m];
#pragma unroll
                for (int bj = 0; bj < 2; ++bj) { const u32x4 r = bv[m][bj]; const f32x4 a0 = acc[ai][bj][m][0], a1 = acc[ai][bj][m][1];
                    f32x4 o0, o1;
                    o0[0] = bf_lo(r.x) * k + a0[0]; o0[1] = bf_hi(r.x) * k + a0[1]; o0[2] = bf_lo(r.y) * k + a0[2]; o0[3] = bf_hi(r.y) * k + a0[3];
                    o1[0] = bf_lo(r.z) * k + a1[0]; o1[1] = bf_hi(r.z) * k + a1[1]; o1[2] = bf_lo(r.w) * k + a1[2]; o1[3] = bf_hi(r.w) * k + a1[3];
                    ss += ((o0[0] * o0[0] + o0[1] * o0[1]) + (o0[2] * o0[2] + o0[3] * o0[3])) + ((o1[0] * o1[0] + o1[1] * o1[1]) + (o1[2] * o1[2] + o1[3] * o1[3]));
                    u32x4 w; w.x = cvt_pk_bf16(o0[0], o0[1]); w.y = cvt_pk_bf16(o0[2], o0[3]); w.z = cvt_pk_bf16(o1[0], o1[1]); w.w = cvt_pk_bf16(o1[2], o1[3]);
                    *(u32x4*)(xb + (size_t)row * D + col0 + bj * HALF) = w; }
                if (ai == 0) { sc[m] = rowscale ? rowscale[row + HALF] : 1.0f;
#pragma unroll
                    for (int bj = 0; bj < 2; ++bj) bv[m][bj] = *(const u32x4*)(base + (size_t)(row + HALF) * D + col0 + bj * HALF); }
                ss = fq_sum(ss);
                if (fq == 0) ps[(size_t)row * 16 + u.pn * 4 + wc] = ss; }
    }
};

template <class Epi, class Sched, bool ALIGN_EPI = false, bool SP2 = false>
__device__ __forceinline__ void gemm_phase(PG8_LAS unsigned char* lds, const Gemm g, const Sched& S, const Epi& E, int wave_) {
    int l_ = lane_id(); asm volatile("" : "+v"(l_)); l_ &= 63;
    const int wid = wave_ & 7, tid = wid * 64 + l_, lane = tid & 63, wr = wid >> 2, wc = wid & 3, fr = lane & 15, fq = lane >> 4;
    const int K = g.K, nt = K / BK;
    unsigned voffA[2], voffB[2];
#pragma unroll
    for (int i = 0; i < 2; ++i) { int R, C; stage_rc(tid * 16 + i * 8192, R, C); const int Rb = Epi::PERM ? ((R & ~31) + perm32(R & 31)) : R;
        voffA[i] = (unsigned)(R * K + C) * 2u; voffB[i] = (unsigned)(Rb * K + C) * 2u; }
    const size_t kstep = (size_t)(BK * 2);
    const size_t hstep = (size_t)HALF * K * 2;
    const size_t tstep = 2 * hstep;
    const unsigned ldsw = (unsigned)wid * 1024u;
    const int aoff = lds_byte(wr * 64 + fr, fq * 8), boff = lds_byte(wc * 32 + fr, fq * 8);
#define PG8_SA(b, h) (((b) * 2 + (h)) * HTB)
#define PG8_SB(b, h) ((4 + (b) * 2 + (h)) * HTB)
#define PG8_STAGE(bufoff, gbase, voff) do { _Pragma("unroll") for (int _i = 0; _i < 2; ++_i) \
        __builtin_amdgcn_global_load_lds((const unsigned*)((const char*)(gbase) + (voff)[_i]), (PG8_LAS unsigned*)(lds + (bufoff) + ldsw + _i * 8192), 16, 0, 0); } while (0)
#define PG8_LDA(dst, b, h) do { _Pragma("unroll") for (int m = 0; m < 4; ++m) _Pragma("unroll") for (int k = 0; k < 2; ++k) dst[m][k] = *(const PG8_LAS bf16x8*)(lds + PG8_SA(b, h) + aoff + m * 2048 + k * 1024); } while (0)
#define PG8_LDB(dst, b, h) do { _Pragma("unroll") for (int n = 0; n < 2; ++n) _Pragma("unroll") for (int k = 0; k < 2; ++k) dst[n][k] = *(const PG8_LAS bf16x8*)(lds + PG8_SB(b, h) + boff + n * 2048 + k * 1024); } while (0)
#define PG8_MMA(ai, bj, At, Bt) do { __builtin_amdgcn_s_setprio(1); _Pragma("unroll") for (int m = 0; m < 4; ++m) _Pragma("unroll") for (int n = 0; n < 2; ++n) _Pragma("unroll") for (int k = 0; k < 2; ++k) \
        acc[ai][bj][m][n] = __builtin_amdgcn_mfma_f32_16x16x32_bf16(Bt[n][k], At[m][k], acc[ai][bj][m][n], 0, 0, 0); __builtin_amdgcn_s_setprio(0); } while (0)
#define PG8_WAIT_V(n) asm volatile("s_waitcnt vmcnt(" #n ")" ::: "memory")
#define PG8_WAIT_L(n) asm volatile("s_waitcnt lgkmcnt(" #n ")" ::: "memory")
#define PG8_BAR __builtin_amdgcn_s_barrier()
#define PG8_SCHED __builtin_amdgcn_sched_barrier(0)
    Unit cur, nxt; int ui = 0;
    if (!S.next(0, cur)) return;
    f32x4 acc[2][2][4][2];
#pragma unroll
    for (int a = 0; a < 2; ++a)
#pragma unroll
        for (int b = 0; b < 2; ++b)
#pragma unroll
            for (int m = 0; m < 4; ++m)
#pragma unroll
                for (int n = 0; n < 2; ++n) acc[a][b][m][n] = (f32x4){0.f, 0.f, 0.f, 0.f};
    bf16x8 At[4][2], B0[2][2], B1[2][2];
    const char* cA = (const char*)g.A + (size_t)cur.pm * tstep; const char* cB = (const char*)g.Bt + (size_t)cur.pn * tstep;
    S.a_ready(cur); E.unit_begin(cur, lds, wid, lane);
    if constexpr (SP2) {
        PG8_STAGE(PG8_SB(0, 0), cB, voffB); PG8_STAGE(PG8_SB(0, 1), cB + hstep, voffB); PG8_STAGE(PG8_SA(0, 0), cA, voffA); PG8_STAGE(PG8_SA(0, 1), cA + hstep, voffA);
        if (wr == 1) PG8_BAR;
        PG8_WAIT_V(2); PG8_BAR;
        PG8_STAGE(PG8_SB(1, 0), cB + kstep, voffB); PG8_STAGE(PG8_SA(1, 0), cA + kstep, voffA); PG8_STAGE(PG8_SB(1, 1), cB + hstep + kstep, voffB);
        PG8_WAIT_V(6); PG8_BAR;
    } else {
        PG8_STAGE(PG8_SB(0, 0), cB, voffB); PG8_STAGE(PG8_SA(0, 0), cA, voffA); PG8_STAGE(PG8_SB(0, 1), cB + hstep, voffB); PG8_STAGE(PG8_SA(0, 1), cA + hstep, voffA);
        if (wr == 1) PG8_BAR;
        PG8_WAIT_V(4); PG8_BAR;
        PG8_STAGE(PG8_SB(1, 0), cB + kstep, voffB); PG8_STAGE(PG8_SA(1, 0), cA + kstep, voffA); PG8_STAGE(PG8_SB(1, 1), cB + hstep + kstep, voffB);
        PG8_WAIT_V(6); PG8_BAR;
    }
    for (;;) {
        const bool has_next = S.next(ui + 1, nxt);
        const char* nA = has_next ? (const char*)g.A + (size_t)nxt.pm * tstep : cA; const char* nB = has_next ? (const char*)g.Bt + (size_t)nxt.pn * tstep : cB;
        for (int t = 0; t < nt; t += 2) {
            const bool last = (t == nt - 2);
            const char* a1 = cA + (size_t)(t + 1) * kstep;
            const char* a2 = last ? nA : cA + (size_t)(t + 2) * kstep; const char* b2 = last ? nB : cB + (size_t)(t + 2) * kstep;
            const char* a3 = a2 + kstep; const char* b3 = b2 + kstep;
            if (last && has_next) S.a_ready(nxt);
            if constexpr (SP2) {
            PG8_LDB(B0, 0, 0); PG8_LDB(B1, 0, 1); PG8_SCHED; PG8_LDA(At, 0, 0); PG8_STAGE(PG8_SA(1, 1), a1 + hstep, voffA);
            PG8_WAIT_V(8); PG8_WAIT_L(0); PG8_BAR; PG8_MMA(0, 0, At, B0); PG8_MMA(0, 1, At, B1); PG8_BAR; PG8_SCHED;
            PG8_LDA(At, 0, 1); PG8_STAGE(PG8_SB(0, 0), b2, voffB); PG8_STAGE(PG8_SB(0, 1), b2 + hstep, voffB); PG8_STAGE(PG8_SA(0, 0), a2, voffA);
            PG8_WAIT_V(8); PG8_WAIT_L(0); PG8_BAR; PG8_MMA(1, 0, At, B0); PG8_MMA(1, 1, At, B1); PG8_BAR; PG8_SCHED;
            PG8_LDB(B0, 1, 0); PG8_LDB(B1, 1, 1); PG8_SCHED; PG8_LDA(At, 1, 0); PG8_STAGE(PG8_SA(0, 1), a2 + hstep, voffA);
            PG8_WAIT_V(8); PG8_WAIT_L(0); PG8_BAR; PG8_MMA(0, 0, At, B0); PG8_MMA(0, 1, At, B1); PG8_BAR; PG8_SCHED;
            PG8_LDA(At, 1, 1); PG8_STAGE(PG8_SB(1, 0), b3, voffB); PG8_STAGE(PG8_SB(1, 1), b3 + hstep, voffB); PG8_STAGE(PG8_SA(1, 0), a3, voffA);
            PG8_WAIT_V(8); PG8_WAIT_L(0); PG8_BAR; PG8_MMA(1, 0, At, B0); PG8_MMA(1, 1, At, B1); PG8_BAR; PG8_SCHED;
            } else {
            PG8_LDB(B0, 0, 0); PG8_SCHED; PG8_LDA(At, 0, 0); PG8_STAGE(PG8_SA(1, 1), a1 + hstep, voffA);
            PG8_WAIT_L(8); PG8_BAR; PG8_WAIT_L(0); PG8_MMA(0, 0, At, B0); PG8_BAR; PG8_SCHED;
            PG8_LDB(B1, 0, 1); PG8_STAGE(PG8_SB(0, 0), b2, voffB);
            PG8_BAR; PG8_WAIT_L(0); PG8_MMA(0, 1, At, B1); PG8_BAR;
            PG8_LDA(At, 0, 1); PG8_STAGE(PG8_SA(0, 0), a2, voffA);
            PG8_BAR; PG8_WAIT_L(0); PG8_MMA(1, 0, At, B0); PG8_BAR; PG8_SCHED;
            PG8_STAGE(PG8_SB(0, 1), b2 + hstep, voffB);
            PG8_WAIT_V(6); PG8_BAR; PG8_MMA(1, 1, At, B1); PG8_BAR;
            PG8_LDB(B0, 1, 0); PG8_SCHED; PG8_LDA(At, 1, 0); PG8_STAGE(PG8_SA(0, 1), a2 + hstep, voffA);
            PG8_WAIT_L(8); PG8_BAR; PG8_WAIT_L(0); PG8_MMA(0, 0, At, B0); PG8_BAR; PG8_SCHED;
            PG8_LDB(B1, 1, 1); PG8_STAGE(PG8_SB(1, 0), b3, voffB);
            PG8_BAR; PG8_WAIT_L(0); PG8_MMA(0, 1, At, B1); PG8_BAR;
            PG8_LDA(At, 1, 1); PG8_STAGE(PG8_SA(1, 0), a3, voffA);
            PG8_BAR; PG8_WAIT_L(0); PG8_MMA(1, 0, At, B0); PG8_BAR; PG8_SCHED;
            PG8_STAGE(PG8_SB(1, 1), b3 + hstep, voffB);
            PG8_WAIT_V(6); PG8_BAR; PG8_MMA(1, 1, At, B1); PG8_BAR;
            }
        }
        if constexpr (ALIGN_EPI) { if (wr == 0) PG8_BAR; }
        E(acc, cur, tid, lds, wr, wc, fr, fq); S.done(cur);
        if (!has_next) break;
#pragma unroll
        for (int a = 0; a < 2; ++a)
#pragma unroll
            for (int b = 0; b < 2; ++b)
#pragma unroll
                for (int m = 0; m < 4; ++m)
#pragma unroll
                    for (int n = 0; n < 2; ++n) acc[a][b][m][n] = (f32x4){0.f, 0.f, 0.f, 0.f};
        cur = nxt; cA = nA; cB = nB; ++ui;
        if constexpr (ALIGN_EPI) { if (wr == 1) PG8_BAR; }
        E.unit_begin(cur, lds, wid, lane);
    }
    PG8_WAIT_V(0);
    if constexpr (!ALIGN_EPI) { if (wr == 0) PG8_BAR; }
    PG8_BAR;
#undef PG8_SA
#undef PG8_SB
#undef PG8_STAGE
#undef PG8_LDA
#undef PG8_LDB
#undef PG8_MMA
#undef PG8_WAIT_V
#undef PG8_WAIT_L
#undef PG8_BAR
#undef PG8_SCHED
}
}

constexpr int NWAVES = 8, NTHREADS = NWAVES * 64;
constexpr int RING_BYTES = 131072;
constexpr int LDS_BYTES = 148992;
struct Frame {
    LAS unsigned char* lds;
    int tid, lane, wave, G, bid;
    const float* const* in;
    float* out;
    unsigned char* ws;
};
enum InIdx { I_X = 0, I_MEM, I_LN_MIX_G, I_W_IN, I_SGU_LN_G, I_SGU_LN_B, I_W_SPATIAL, I_B_SPATIAL, I_CONV_W, I_GRP_A, I_GRP_B, I_W_OUT, I_LN_ATTN_G, I_LN_MEM_G,
             I_W_Q, I_W_KV, I_W_O, I_LN_FFN_G, I_W_GU, I_W_DOWN, I_LN_FINAL_G };

__device__ __forceinline__ void p0_transpose_item(const float* W, int K, int N, bf16_t* WT, const float* gain, int k0, int sc0, int dn0, LAS float* scr, int lane) {
    const int rq = lane >> 4, cq = lane & 15;
    f32x4 v[16];
#pragma unroll
    for (int i = 0; i < 16; ++i) v[i] = *(const f32x4*)(W + (size_t)(k0 + 4 * i + rq) * N + sc0 + 4 * cq);
    if (gain) {
#pragma unroll
        for (int i = 0; i < 16; ++i) v[i] = v[i] * gain[k0 + 4 * i + rq]; }
#pragma unroll
    for (int i = 0; i < 16; ++i) { LAS float* d = scr + (4 * i + rq) * 65 + 4 * cq; d[0] = v[i][0]; d[1] = v[i][1]; d[2] = v[i][2]; d[3] = v[i][3]; }
    asm volatile("s_waitcnt lgkmcnt(0)" ::: "memory");
    const int c = lane & 7;
#pragma unroll
    for (int j = 0; j < 8; ++j) { const int n = (lane >> 3) + 8 * j; const LAS float* s_ = scr + (8 * c) * 65 + n;
        u32x4 o; o.x = pk2(s_[0 * 65], s_[1 * 65]); o.y = pk2(s_[2 * 65], s_[3 * 65]); o.z = pk2(s_[4 * 65], s_[5 * 65]); o.w = pk2(s_[6 * 65], s_[7 * 65]);
        *(u32x4*)(WT + (size_t)(dn0 + n) * K + k0 + 8 * c) = o; }
    asm volatile("s_waitcnt lgkmcnt(0)" ::: "memory");
}
template <int NR>
__device__ __forceinline__ void rms_rows_to_bf16(const float* x, bf16_t* o, float* inv, int m0, int stride, int lane) {
    f32x4 v[NR][4];
#pragma unroll
    for (int r = 0; r < NR; ++r) { const f32x4* xr = (const f32x4*)(x + (size_t)(m0 + r * stride) * D) + lane;
#pragma unroll
        for (int j = 0; j < 4; ++j) v[r][j] = xr[64 * j]; }
#pragma unroll
    for (int r = 0; r < NR; ++r) { float s = 0.f;
#pragma unroll
        for (int j = 0; j < 4; ++j) s += (v[r][j][0] * v[r][j][0] + v[r][j][1] * v[r][j][1]) + (v[r][j][2] * v[r][j][2] + v[r][j][3] * v[r][j][3]);
        const float ms = wave_sum(s) * (1.f / D) + EPS; const float rstd = __builtin_amdgcn_rsqf(ms);
        if (inv && lane == 0) inv[m0 + r * stride] = ms * rstd;
        unsigned long long* o8 = (unsigned long long*)(o + (size_t)(m0 + r * stride) * D) + lane;
#pragma unroll
        for (int j = 0; j < 4; ++j) o8[64 * j] = (unsigned long long)pk2(v[r][j][0] * rstd, v[r][j][1] * rstd) | ((unsigned long long)pk2(v[r][j][2] * rstd, v[r][j][3] * rstd) << 32); }
}
__device__ __forceinline__ void p0_prologue(Frame& F) {
    LAS float* scr = (LAS float*)(F.lds + F.wave * 16640);
    const int gw = F.bid * NWAVES + F.wave, NGW = F.G * NWAVES;
    bf16_t* Win_t = (bf16_t*)(F.ws + WS_WIN); bf16_t* Wout_t = (bf16_t*)(F.ws + WS_WOUT); bf16_t* Wq_t = (bf16_t*)(F.ws + WS_WQ); bf16_t* Wkv_t = (bf16_t*)(F.ws + WS_WKV);
    bf16_t* Wo_t = (bf16_t*)(F.ws + WS_WO); bf16_t* Wgu_t = (bf16_t*)(F.ws + WS_WGU); bf16_t* Wdn_t = (bf16_t*)(F.ws + WS_WDN);
    constexpr int IT_IN = (D / 64) * (NIN / 64), IT_SQ = (D / 64) * (D / 64), IT_KV = (D / 64) * (2 * D / 64), IT_GU = (D / 64) * (NGU / 64), IT_DN = (DFF / 64) * (D / 64);
    constexpr int NITEMS = IT_IN + 3 * IT_SQ + IT_KV + IT_GU + IT_DN;
    for (int it = gw; it < NITEMS; it += NGW) {
        int r = it;
        if (r < IT_IN) { const int nb = r % (NIN / 64), kb = r / (NIN / 64); p0_transpose_item(F.in[I_W_IN], D, NIN, Win_t, F.in[I_LN_MIX_G], 64 * kb, 64 * nb, 64 * nb, scr, F.lane); continue; } r -= IT_IN;
        if (r < IT_SQ) { const int nb = r % (D / 64), kb = r / (D / 64); const int k0 = 64 * kb;
            const float* gain = (k0 < 512) ? F.in[I_GRP_A] : (F.in[I_GRP_B] - 512);
            p0_transpose_item(F.in[I_W_OUT], D, D, Wout_t, gain, k0, 64 * nb, 64 * nb, scr, F.lane); continue; } r -= IT_SQ;
        if (r < IT_SQ) { const int nb = r % (D / 64), kb = r / (D / 64); p0_transpose_item(F.in[I_W_Q], D, D, Wq_t, F.in[I_LN_ATTN_G], 64 * kb, 64 * nb, 64 * nb, scr, F.lane); continue; } r -= IT_SQ;
        if (r < IT_SQ) { const int nb = r % (D / 64), kb = r / (D / 64); p0_transpose_item(F.in[I_W_O], D, D, Wo_t, nullptr, 64 * kb, 64 * nb, 64 * nb, scr, F.lane); continue; } r -= IT_SQ;
        if (r < IT_KV) { const int nb = r % (2 * D / 64), kb = r / (2 * D / 64); p0_transpose_item(F.in[I_W_KV], D, 2 * D, Wkv_t, F.in[I_LN_MEM_G], 64 * kb, 64 * nb, 64 * nb, scr, F.lane); continue; } r -= IT_KV;
        if (r < IT_GU) { const int nb = r % (NGU / 64), kb = r / (NGU / 64); const int dn0 = 64 * nb, tile = dn0 >> 8, j = dn0 & 255;
            const int sc0 = (j < 128) ? (128 * tile + j) : (DFF + 128 * tile + (j - 128));
            p0_transpose_item(F.in[I_W_GU], D, NGU, Wgu_t, F.in[I_LN_FFN_G], 64 * kb, sc0, dn0, scr, F.lane); continue; } r -= IT_GU;
        { const int nb = r % (D / 64), kb = r / (D / 64); p0_transpose_item(F.in[I_W_DOWN], DFF, D, Wdn_t, nullptr, 64 * kb, 64 * nb, 64 * nb, scr, F.lane); }
    }
    { bf16_t* Wm = (bf16_t*)(F.ws + WS_WM); const float* wsp = F.in[I_W_SPATIAL];
      for (int i = F.bid * NTHREADS + F.tid; i < 4 * 128 * 128; i += F.G * NTHREADS) { const int s = i & 127, t = (i >> 7) & 127; Wm[i] = (bf16_t)(s <= t ? f2bf(wsp[i]) : 0u); } }
    bf16_t* XB = (bf16_t*)(F.ws + WS_XB); bf16_t* MEMN = (bf16_t*)(F.ws + WS_MEMN);
    float* RX = (float*)(F.ws + WS_RX);
    for (int m = gw; m < M; m += 4 * NGW) rms_rows_to_bf16<4>(F.in[I_X], XB, RX, m, NGW, F.lane);
    for (int m = gw; m < MROWS; m += NGW) rms_rows_to_bf16<1>(F.in[I_MEM], MEMN, nullptr, m, NGW, F.lane);
}

constexpr int VS = 1040;
__device__ __forceinline__ s16x4 tr_read(const LAS unsigned char* p) { return __builtin_bit_cast(s16x4, __builtin_amdgcn_ds_read_tr16_b64_v4i16((LAS s16x4*)p)); }
__device__ __forceinline__ void unpack8(const u32x4 w, float* v) { v[0] = bf_lo(w.x); v[1] = bf_hi(w.x); v[2] = bf_lo(w.y); v[3] = bf_hi(w.y); v[4] = bf_lo(w.z); v[5] = bf_hi(w.z); v[6] = bf_lo(w.w); v[7] = bf_hi(w.w); }
__device__ __forceinline__ void p2_sgu_conv(Frame& F) {
    const bf16_t* H = (const bf16_t*)(F.ws + WS_H); bf16_t* Y = (bf16_t*)(F.ws + WS_Y); const bf16_t* Wm = (const bf16_t*)(F.ws + WS_WM);
    const int w = F.wave;
    for (int ch = F.bid; ch < NCHUNK; ch += F.G) {
        int lane = F.lane; asm volatile("" : "+v"(lane));
        const int fr = lane & 15, fq = lane >> 4;
        const int row0 = ch * CHUNK; const bool first = (ch % (SEQ / CHUNK)) == 0;
        const bf16_t* Hc = H + (size_t)row0 * NIN;
        { float lg[8], lb[8];
          { const f32x4* p = (const f32x4*)(F.in[I_SGU_LN_G] + 8 * lane); f32x4 a = p[0], b = p[1]; for (int i = 0; i < 4; ++i) { lg[i] = a[i]; lg[4 + i] = b[i]; }
            p = (const f32x4*)(F.in[I_SGU_LN_B] + 8 * lane); a = p[0]; b = p[1]; for (int i = 0; i < 4; ++i) { lb[i] = a[i]; lb[4 + i] = b[i]; } }
#pragma unroll 4
        for (int r = 0; r < 16; ++r) { const int row = 16 * w + r;
            float v[8]; unpack8(*(const u32x4*)(Hc + (size_t)row * NIN + 512 + 8 * lane), v);
            float s = 0.f;
#pragma unroll
            for (int i = 0; i < 8; ++i) s += v[i];
            const float mu = wave_sum(s) * (1.f / 512.f); float q = 0.f;
#pragma unroll
            for (int i = 0; i < 8; ++i) { v[i] -= mu; q += v[i] * v[i]; }
            const float rstd = __builtin_amdgcn_rsqf(wave_sum(q) * (1.f / 512.f) + EPS);
#pragma unroll
            for (int i = 0; i < 8; ++i) v[i] = v[i] * rstd * lg[i] + lb[i];
            u32x4 o; o.x = pk2(v[0], v[1]); o.y = pk2(v[2], v[3]); o.z = pk2(v[4], v[5]); o.w = pk2(v[6], v[7]);
            *(LAS u32x4*)(F.lds + row * VS + lane * 16) = o; } }
        { float z1[8], z2[8], cw0[8], cw1[8], cw2[8];
          { const f32x4* p = (const f32x4*)(F.in[I_CONV_W] + 8 * lane); f32x4 a = p[0], b = p[1]; for (int i = 0; i < 4; ++i) { cw0[i] = a[i]; cw0[4 + i] = b[i]; }
            p = (const f32x4*)(F.in[I_CONV_W] + 512 + 8 * lane); a = p[0]; b = p[1]; for (int i = 0; i < 4; ++i) { cw1[i] = a[i]; cw1[4 + i] = b[i]; }
            p = (const f32x4*)(F.in[I_CONV_W] + 1024 + 8 * lane); a = p[0]; b = p[1]; for (int i = 0; i < 4; ++i) { cw2[i] = a[i]; cw2[4 + i] = b[i]; } }
#pragma unroll
          for (int i = 0; i < 8; ++i) { z1[i] = 0.f; z2[i] = 0.f; }
          if (!(first && w == 0)) {
              float a[8], b[8];
              unpack8(*(const u32x4*)(Hc + (long)(16 * w - 2) * NIN + 1536 + 8 * lane), a); unpack8(*(const u32x4*)(Hc + (long)(16 * w - 2) * NIN + 2048 + 8 * lane), b);
#pragma unroll
              for (int i = 0; i < 8; ++i) z2[i] = a[i] * b[i];
              unpack8(*(const u32x4*)(Hc + (long)(16 * w - 1) * NIN + 1536 + 8 * lane), a); unpack8(*(const u32x4*)(Hc + (long)(16 * w - 1) * NIN + 2048 + 8 * lane), b);
#pragma unroll
              for (int i = 0; i < 8; ++i) z1[i] = a[i] * b[i];
          }
#pragma unroll 4
          for (int r = 0; r < 16; ++r) { const int row = 16 * w + r; const bf16_t* hp = Hc + (size_t)row * NIN + 8 * lane;
              float gb[8], gc[8], vl[8]; unpack8(*(const u32x4*)(hp + 1024), gb); unpack8(*(const u32x4*)(hp + 1536), gc); unpack8(*(const u32x4*)(hp + 2048), vl);
              float yb[8]; float ss = 0.f;
#pragma unroll
              for (int i = 0; i < 8; ++i) { const float z0 = gc[i] * vl[i]; const float cv = cw0[i] * z2[i] + cw1[i] * z1[i] + cw2[i] * z0; yb[i] = gb[i] * cv; ss += yb[i] * yb[i]; z2[i] = z1[i]; z1[i] = z0; }
              const float rs = __builtin_amdgcn_rsqf(wave_sum(ss) * (1.f / 512.f) + EPS);
              u32x4 o; o.x = pk2(yb[0] * rs, yb[1] * rs); o.y = pk2(yb[2] * rs, yb[3] * rs); o.z = pk2(yb[4] * rs, yb[5] * rs); o.w = pk2(yb[6] * rs, yb[7] * rs);
              *(u32x4*)(Y + (size_t)(row0 + row) * D + 512 + 8 * lane) = o; } }
        __syncthreads();
        { f32x4 acc[32];
#pragma unroll
          for (int i = 0; i < 32; ++i) acc[i] = (f32x4){0.f, 0.f, 0.f, 0.f};
          const int T0 = 16 * w, nks = (w >> 1) + 1;
          const int q = (lane & 15) >> 2, p = lane & 3;
          for (int ks = 0; ks < nks; ++ks) {
              const LAS unsigned char* vb = F.lds + (32 * ks + 8 * fq + q) * VS + 8 * p;
#pragma unroll
              for (int h = 0; h < 4; ++h) {
                  const bf16x8 wf = *(const bf16x8*)(Wm + ((size_t)(h * 128 + T0 + fr) * 128 + 32 * ks + 8 * fq));
#pragma unroll
                  for (int nt = 0; nt < 8; ++nt) { const int c0 = 128 * h + 16 * nt;
                      const s16x4 lo = tr_read(vb + c0 * 2), hi = tr_read(vb + 4 * VS + c0 * 2);
                      const bf16x8 vf = (bf16x8){lo[0], lo[1], lo[2], lo[3], hi[0], hi[1], hi[2], hi[3]};
                      acc[h * 8 + nt] = __builtin_amdgcn_mfma_f32_16x16x32_bf16(vf, wf, acc[h * 8 + nt], 0, 0, 0); } } }
          const int trow = T0 + fr; const bf16_t* up = Hc + (size_t)trow * NIN; float ss = 0.f;
#pragma unroll
          for (int h = 0; h < 4; ++h) { const float bs = F.in[I_B_SPATIAL][h * 128 + trow];
#pragma unroll
              for (int nt = 0; nt < 8; ++nt) { const int c = 128 * h + 16 * nt + 4 * fq; const u32x2 uw = *(const u32x2*)(up + c);
                  f32x4 a = acc[h * 8 + nt]; a[0] = bf_lo(uw.x) * (a[0] + bs); a[1] = bf_hi(uw.x) * (a[1] + bs); a[2] = bf_lo(uw.y) * (a[2] + bs); a[3] = bf_hi(uw.y) * (a[3] + bs);
                  ss += (a[0] * a[0] + a[1] * a[1]) + (a[2] * a[2] + a[3] * a[3]); acc[h * 8 + nt] = a; }
              asm volatile("" ::: "memory"); }
          ss = fq_sum(ss);
          const float rs = __builtin_amdgcn_rsqf(ss * (1.f / 512.f) + EPS);
          bf16_t* yp = Y + (size_t)(row0 + trow) * D;
#pragma unroll
          for (int i = 0; i < 32; ++i) { const int c = 16 * i + 4 * fq; const f32x4 a = acc[i] * rs; u32x2 o; o.x = pk2(a[0], a[1]); o.y = pk2(a[2], a[3]); *(u32x2*)(yp + c) = o; } }
        __syncthreads();
    }
}

constexpr int KS_B = 528, HB_B = 128 * KS_B;
__device__ __forceinline__ void att_issue(u32x4 (&v)[16], const bf16_t* src, int tid) {
    const unsigned voff = (unsigned)(tid >> 5) * 4096u + (unsigned)(tid & 31) * 16u;
#pragma unroll
    for (int i = 0; i < 16; ++i) v[i] = *(const u32x4*)((const char*)src + (size_t)i * 65536 + voff);
}
__device__ __forceinline__ void att_write(LAS unsigned char* lds, const u32x4 (&v)[16], int tid) {
    LAS unsigned char* d = lds + (tid >> 5) * KS_B + (tid & 31) * 16;
#pragma unroll
    for (int i = 0; i < 16; ++i) *(LAS u32x4*)(d + i * 16 * KS_B) = v[i];
}
__device__ __forceinline__ void p5_attention(Frame& F) {
    const bf16_t* Q = (const bf16_t*)(F.ws + WS_Q); const bf16_t* KV = (const bf16_t*)(F.ws + WS_KV); bf16_t* O = (bf16_t*)(F.ws + WS_O);
    const int lane = F.lane, w = F.wave, fr = lane & 15, fq = lane >> 4, q4 = (lane & 15) >> 2, p4 = lane & 3;
    constexpr int NUNITS = BATCH * 4 * (SEQ / 128);
    u32x4 sv[16]; bf16x8 qf[8];
    int id = F.bid;
    if (id < NUNITS) { const int bh = id >> 5, qb = id & 31, b = bh >> 2, h = bh & 3;
        att_issue(sv, KV + (size_t)(b * MEML) * 2048 + h * 256, F.tid);
        const size_t qrow = (size_t)b * SEQ + qb * 128 + 16 * w + fr;
#pragma unroll
        for (int ks = 0; ks < 8; ++ks) qf[ks] = *(const bf16x8*)(Q + qrow * D + h * 256 + 32 * ks + 8 * fq); }
    for (; id < NUNITS; id += F.G) {
        const int bh = id >> 5, qb = id & 31, b = bh >> 2, h = bh & 3;
        const bf16_t* Vg = KV + (size_t)(b * MEML) * 2048 + h * 256 + 1024;
        const size_t qrow = (size_t)b * SEQ + qb * 128 + 16 * w + fr;
        att_write(F.lds, sv, F.tid);
        __syncthreads();
        att_issue(sv, Vg, F.tid);
        f32x4 st[16];
        const LAS unsigned char* kbase = F.lds + fr * KS_B + fq * 16;
#pragma unroll
        for (int kt = 0; kt < 16; kt += 2) { st[kt] = (f32x4){0.f, 0.f, 0.f, 0.f}; st[kt + 1] = (f32x4){0.f, 0.f, 0.f, 0.f};
            const LAS unsigned char* kb0 = kbase + kt * 16 * KS_B; const LAS unsigned char* kb1 = kb0 + 16 * KS_B;
#pragma unroll
            for (int ks = 0; ks < 8; ++ks) { const bf16x8 k0 = *(const LAS bf16x8*)(kb0 + ks * 64), k1 = *(const LAS bf16x8*)(kb1 + ks * 64);
                st[kt] = __builtin_amdgcn_mfma_f32_16x16x32_bf16(k0, qf[ks], st[kt], 0, 0, 0); st[kt + 1] = __builtin_amdgcn_mfma_f32_16x16x32_bf16(k1, qf[ks], st[kt + 1], 0, 0, 0);
                if ((ks & 3) == 3) __builtin_amdgcn_sched_barrier(0); } }
        float mx = -3.0e38f;
#pragma unroll
        for (int kt = 0; kt < 16; ++kt) mx = fmaxf(mx, fmaxf(fmaxf(st[kt][0], st[kt][1]), fmaxf(st[kt][2], st[kt][3])));
        mx = fq_max(mx);
        float l = 0.f;
#pragma unroll
        for (int kt = 0; kt < 16; ++kt) {
#pragma unroll
            for (int i = 0; i < 4; ++i) { const float e = __builtin_amdgcn_exp2f(st[kt][i] - mx); st[kt][i] = e; l += e; } }
        l = fq_sum(l);
        bf16x8 pk[8];
#pragma unroll
        for (int kk = 0; kk < 8; ++kk) { u32x4 wv; wv.x = pk2(st[2 * kk][0], st[2 * kk][1]); wv.y = pk2(st[2 * kk][2], st[2 * kk][3]); wv.z = pk2(st[2 * kk + 1][0], st[2 * kk + 1][1]); wv.w = pk2(st[2 * kk + 1][2], st[2 * kk + 1][3]);
            pk[kk] = __builtin_bit_cast(bf16x8, wv); }
        __syncthreads();
        att_write(F.lds, sv, F.tid);
        __syncthreads();
        { const int nid = id + F.G;
          if (nid < NUNITS) { const int nbh = nid >> 5, nqb = nid & 31, nb = nbh >> 2, nh = nbh & 3;
              att_issue(sv, KV + (size_t)(nb * MEML) * 2048 + nh * 256, F.tid);
              const size_t nqrow = (size_t)nb * SEQ + nqb * 128 + 16 * w + fr;
#pragma unroll
              for (int ks = 0; ks < 8; ++ks) qf[ks] = *(const bf16x8*)(Q + nqrow * D + nh * 256 + 32 * ks + 8 * fq); } }
        const float inv = 1.0f / l;
        bf16_t* op = O + qrow * D + h * 256 + 4 * fq;
        const LAS unsigned char* vbase = F.lds + (4 * fq + q4) * KS_B + 8 * p4;
#pragma unroll
        for (int dt = 0; dt < 16; dt += 2) { f32x4 o0 = (f32x4){0.f, 0.f, 0.f, 0.f}, o1 = (f32x4){0.f, 0.f, 0.f, 0.f};
#pragma unroll
            for (int kk = 0; kk < 8; ++kk) {
                const LAS unsigned char* vb = vbase + kk * 32 * KS_B + dt * 32;
                const s16x4 lo0 = tr_read(vb), hi0 = tr_read(vb + 16 * KS_B), lo1 = tr_read(vb + 32), hi1 = tr_read(vb + 16 * KS_B + 32);
                const bf16x8 v0 = (bf16x8){lo0[0], lo0[1], lo0[2], lo0[3], hi0[0], hi0[1], hi0[2], hi0[3]}, v1 = (bf16x8){lo1[0], lo1[1], lo1[2], lo1[3], hi1[0], hi1[1], hi1[2], hi1[3]};
                o0 = __builtin_amdgcn_mfma_f32_16x16x32_bf16(v0, pk[kk], o0, 0, 0, 0); o1 = __builtin_amdgcn_mfma_f32_16x16x32_bf16(v1, pk[kk], o1, 0, 0, 0); }
            u32x2 w0; w0.x = pk2(o0[0] * inv, o0[1] * inv); w0.y = pk2(o0[2] * inv, o0[3] * inv); *(u32x2*)(op + 16 * dt) = w0;
            u32x2 w1; w1.x = pk2(o1[0] * inv, o1[1] * inv); w1.y = pk2(o1[2] * inv, o1[3] * inv); *(u32x2*)(op + 16 * dt + 16) = w1; }
        __syncthreads();
    }
}

__device__ __forceinline__ void p9_final(Frame& F, float* dst) {
    const int gw = F.bid * NWAVES + F.wave, NGW = F.G * NWAVES; const float* ps = (const float*)(F.ws + WS_PS3); const bf16_t* XB = (const bf16_t*)(F.ws + WS_XB);
    f32x4 g[4];
#pragma unroll
    for (int j = 0; j < 4; ++j) g[j] = *(const f32x4*)(F.in[I_LN_FINAL_G] + (j >> 1) * 512 + 8 * F.lane + (j & 1) * 4);
    for (int m0 = gw; m0 < M; m0 += 4 * NGW) { u32x4 v[4][2]; float rs[4];
#pragma unroll
        for (int r = 0; r < 4; ++r) { const int m = m0 + r * NGW; rs[r] = rstd_from_ps(ps, m); v[r][0] = *(const u32x4*)(XB + (size_t)m * D + 8 * F.lane); v[r][1] = *(const u32x4*)(XB + (size_t)m * D + 512 + 8 * F.lane); }
#pragma unroll
        for (int r = 0; r < 4; ++r) { const int m = m0 + r * NGW;
#pragma unroll
            for (int hh = 0; hh < 2; ++hh) { float f[8]; unpack8(v[r][hh], f); f32x4 a, b;
#pragma unroll
                for (int i = 0; i < 4; ++i) { a[i] = f[i] * rs[r] * g[2 * hh][i]; b[i] = f[4 + i] * rs[r] * g[2 * hh + 1][i]; }
                f32x4* o = (f32x4*)(dst + (size_t)m * D + hh * 512 + 8 * F.lane); o[0] = a; o[1] = b; } } }
}

template <class Epi>
__global__ __launch_bounds__(256) void gemm_naive(const bf16_t* A, const bf16_t* Bt, Epi epi, int K, int pad_) {
    const int wave = threadIdx.x >> 6, lane = threadIdx.x & 63, fr = lane & 15, fq = lane >> 4;
    const int row0 = blockIdx.y * 64 + (wave >> 1) * 32, col0 = blockIdx.x * 64 + (wave & 1) * 32;
    f32x4 acc[2][2];
    for (int i = 0; i < 2; ++i) for (int j = 0; j < 2; ++j) acc[i][j] = (f32x4){0.f, 0.f, 0.f, 0.f};
    for (int k0 = 0; k0 < K; k0 += 32) { bf16x8 a[2], b[2];
        for (int i = 0; i < 2; ++i) a[i] = *(const bf16x8*)(A + (size_t)(row0 + 16 * i + fr) * K + k0 + 8 * fq);
        for (int j = 0; j < 2; ++j) b[j] = *(const bf16x8*)(Bt + (size_t)(col0 + 16 * j + fr) * K + k0 + 8 * fq);
        for (int i = 0; i < 2; ++i) for (int j = 0; j < 2; ++j) acc[i][j] = __builtin_amdgcn_mfma_f32_16x16x32_bf16(a[i], b[j], acc[i][j], 0, 0, 0); }
    for (int i = 0; i < 2; ++i) for (int j = 0; j < 2; ++j) for (int r = 0; r < 4; ++r) epi(row0 + 16 * i + 4 * fq + r, col0 + 16 * j + fr, acc[i][j][r]);
}
struct NEpiAct { bf16_t* O; int ldc; int gelu_cols; __device__ void operator()(int r, int c, float v) const { if (c < gelu_cols) v = gelu_tanh(v); O[(size_t)r * ldc + c] = (bf16_t)f2bf(v); } };
struct NEpiRes { const float* base; float* out; bf16_t* xb; __device__ void operator()(int r, int c, float v) const { const float o = base[(size_t)r * D + c] + v; out[(size_t)r * D + c] = o; if (xb) xb[(size_t)r * D + c] = (bf16_t)f2bf(o); } };
struct NEpiRowScale { bf16_t* O; const float* ps; int ldc; float scale; __device__ void operator()(int r, int c, float v) const { O[(size_t)r * ldc + c] = (bf16_t)f2bf(v * rstd_from_ps(ps, r) * scale); } };
struct NEpiGUraw { float* T; __device__ void operator()(int r, int c, float v) const { T[(size_t)r * 256 + c] = v; } };
__global__ __launch_bounds__(256) void naive_rowsumsq(const float* R, float* ps) {
    const int row = blockIdx.x * 4 + (threadIdx.x >> 6), lane = threadIdx.x & 63; float s = 0.f;
    for (int j = 0; j < 4; ++j) { const f32x4 v = ((const f32x4*)(R + (size_t)row * D))[64 * j + lane]; s += (v[0] * v[0] + v[1] * v[1]) + (v[2] * v[2] + v[3] * v[3]); }
    s = wave_sum(s); if (lane < 16) ps[(size_t)row * 16 + lane] = lane == 0 ? s : 0.f;
}
__global__ __launch_bounds__(256) void naive_gu(const bf16_t* A, const bf16_t* Wgu_t, const float* ps, bf16_t* HF) {
    const int wave = threadIdx.x >> 6, lane = threadIdx.x & 63, fr = lane & 15, fq = lane >> 4;
    const int row0 = blockIdx.y * 64 + (wave >> 1) * 32, hc0 = blockIdx.x * 32 + (wave & 1) * 16;
    const int tile = hc0 >> 7, j = hc0 & 127; const int brow_g = 256 * tile + j, brow_u = brow_g + 128;
    f32x4 ag[2], au[2];
    for (int i = 0; i < 2; ++i) { ag[i] = (f32x4){0.f, 0.f, 0.f, 0.f}; au[i] = ag[i]; }
    for (int k0 = 0; k0 < D; k0 += 32) { bf16x8 a[2];
        for (int i = 0; i < 2; ++i) a[i] = *(const bf16x8*)(A + (size_t)(row0 + 16 * i + fr) * D + k0 + 8 * fq);
        const bf16x8 bg = *(const bf16x8*)(Wgu_t + (size_t)(brow_g + fr) * D + k0 + 8 * fq), bu = *(const bf16x8*)(Wgu_t + (size_t)(brow_u + fr) * D + k0 + 8 * fq);
        for (int i = 0; i < 2; ++i) { ag[i] = __builtin_amdgcn_mfma_f32_16x16x32_bf16(a[i], bg, ag[i], 0, 0, 0); au[i] = __builtin_amdgcn_mfma_f32_16x16x32_bf16(a[i], bu, au[i], 0, 0, 0); } }
    for (int i = 0; i < 2; ++i) for (int r = 0; r < 4; ++r) { const int row = row0 + 16 * i + 4 * fq + r; const float rs = rstd_from_ps(ps, row);
        HF[(size_t)row * DFF + hc0 + fr] = (bf16_t)f2bf(silu(ag[i][r] * rs) * (au[i][r] * rs)); }
}


constexpr int CW_BAR = 4096;
constexpr size_t CTL_ZERO_BYTES = 64 * 1024;
constexpr int MISC_OFF = 148480;
#define XB_TMO      128
#define XB_XCNT(j)  (256  + 64 * (j))
#define XB_XSUB(j)  (1280 + 64 * (j))
#define XB_XGEN(j)  (2304 + 64 * (j))
#define XB_TOP      3328
#define XB_TOPGEN   3392
#define XCD_BAR_WORDS 3456
#define XB_SPIN_CAP (1u << 18)
__device__ __forceinline__ unsigned xb_ld(unsigned* p)              { return __hip_atomic_load(p, __ATOMIC_RELAXED, __HIP_MEMORY_SCOPE_AGENT); }
__device__ __forceinline__ unsigned xb_add(unsigned* p, unsigned v) { return __hip_atomic_fetch_add(p, v, __ATOMIC_RELAXED, __HIP_MEMORY_SCOPE_AGENT); }
__device__ __forceinline__ unsigned xb_xcc_id() { return (unsigned)__builtin_amdgcn_s_getreg((3 << 11) | 20) & 0xFu; }
#define XB_SPIN(cond, bar) do { unsigned _sp = 0; while (cond) { __builtin_amdgcn_s_sleep(1); \
    if ((++_sp & 255u) == 0u) { if (xb_ld(&(bar)[XB_TMO])) break; if (_sp > XB_SPIN_CAP) { atomicAdd(&(bar)[XB_TMO], 1u); break; } } } } while (0)
struct XcdBarrier { unsigned* bar; unsigned x; volatile LAS unsigned* st; };
__device__ __forceinline__ XcdBarrier xcd_barrier_post(unsigned* bar, volatile LAS unsigned* st, int wave) {
    XcdBarrier b; b.bar = bar; b.x = xb_xcc_id(); b.st = st;
    if (wave == 0 && lane_id() == 0) (void)xb_add(&bar[XB_XCNT(b.x)], 1u);
    return b;
}
__device__ __forceinline__ void xcd_barrier_complete(unsigned* bar, unsigned x, unsigned& nloc, unsigned& nx) {
    const unsigned G = gridDim.x * gridDim.y * gridDim.z;
    unsigned sum, cnt, mine, sp = 0u;
    for (;;) {
        sum = 0u; cnt = 0u; mine = 0u;
#pragma unroll
        for (unsigned j = 0; j < 16; ++j) { const unsigned c = xb_ld(&bar[XB_XCNT(j)]); sum += c; cnt += (c > 0u) ? 1u : 0u; mine = (j == x) ? c : mine; }
        if (sum == G) break;
        __builtin_amdgcn_s_sleep(1);
        if ((++sp & 255u) == 0u) { if (xb_ld(&bar[XB_TMO])) break; if (sp > XB_SPIN_CAP) { atomicAdd(&bar[XB_TMO], 1u); break; } }
    }
    nloc = mine > 0u ? mine : 1u; nx = cnt > 0u ? cnt : 1u;
}
__device__ __forceinline__ void xcd_barrier(const XcdBarrier& b, int wave) {
    asm volatile("s_waitcnt vmcnt(0)" ::: "memory");
    __syncthreads();
    if (wave == 0 && lane_id() == 0) {
        unsigned* bar = b.bar;
        __builtin_amdgcn_s_waitcnt(0);
        unsigned nloc = b.st[0], nx = b.st[1];
        if (nloc == 0u) { xcd_barrier_complete(bar, b.x, nloc, nx); b.st[0] = nloc; b.st[1] = nx; }
        const unsigned old = xb_add(&bar[XB_XSUB(b.x)], 1u);
        const unsigned gen = old / nloc;
        if (old + 1u == (gen + 1u) * nloc) {
            __builtin_amdgcn_fence(__ATOMIC_RELEASE, "agent");
            asm volatile("s_waitcnt vmcnt(0)" ::: "memory");
            const unsigned og = xb_add(&bar[XB_TOP], 1u);
            const unsigned tg = og / nx;
            if (og + 1u == (tg + 1u) * nx) xb_add(&bar[XB_TOPGEN], 1u);
            else XB_SPIN(xb_ld(&bar[XB_TOPGEN]) == tg, bar);
            __builtin_amdgcn_fence(__ATOMIC_ACQUIRE, "agent");
            xb_add(&bar[XB_XGEN(b.x)], 1u);
            asm volatile("s_waitcnt vmcnt(0)" ::: "memory");
        } else {
            XB_SPIN(xb_ld(&bar[XB_XGEN(b.x)]) == gen, bar);
            __builtin_amdgcn_fence(__ATOMIC_ACQUIRE, "agent");
            asm volatile("s_waitcnt vmcnt(0)" ::: "memory");
        }
    }
    __syncthreads();
}

__device__ __forceinline__ void make_frame(Frame& F, const Params& p, unsigned char* lds) {
    F.lds = (LAS unsigned char*)lds; F.wave = wave_id(); F.lane = lane_id(); F.tid = F.wave * 64 + F.lane; F.G = gridDim.x; F.bid = blockIdx.x;
    F.in = p.in; F.out = p.out; F.ws = p.ws;
}
#define GEMM_PHASE(EpiT, Aptr, Bptr, Mv, Nv, Kv, ...) do { pg8::Gemm g_{(const bf16_t*)(Aptr), (const bf16_t*)(Bptr), Mv, Nv, Kv}; pg8::StaticOrder S_; S_.init(Mv, Nv, F.G, F.bid); \
    pg8::EpiT E_{__VA_ARGS__}; pg8::gemm_phase<pg8::EpiT, pg8::StaticOrder, true, true>(F.lds, g_, S_, E_, F.wave); } while (0)

template <int PH>
__device__ __forceinline__ void run_phase(Frame& F) {
    unsigned char* ws = F.ws;
    { int l = lane_id(); asm volatile("" : "+v"(l)); l &= 63; F.lane = l; F.tid = (F.wave & 7) * 64 + l; }
    if constexpr (PH == 0) p0_prologue(F);
    if constexpr (PH == 1) {
        GEMM_PHASE(EpiAct, ws + WS_MEMN, ws + WS_WKV, MROWS, 2 * D, D, (bf16_t*)(ws + WS_KV), 2 * D, 0);
        GEMM_PHASE(EpiAct, ws + WS_XB, ws + WS_WIN, M, NIN, D, (bf16_t*)(ws + WS_H), NIN, 1024);
    }
    if constexpr (PH == 2) p2_sgu_conv(F);
    if constexpr (PH == 3) GEMM_PHASE(EpiRes, ws + WS_Y, ws + WS_WOUT, M, D, D, (const bf16_t*)(ws + WS_XB), (bf16_t*)(ws + WS_XB), (float*)(ws + WS_PS1), (const float*)(ws + WS_RX));
    if constexpr (PH == 4) GEMM_PHASE(EpiRowScale, ws + WS_XB, ws + WS_WQ, M, D, D, (bf16_t*)(ws + WS_Q), D, (const float*)(ws + WS_PS1), QSCALE);
    if constexpr (PH == 5) p5_attention(F);
    if constexpr (PH == 6) GEMM_PHASE(EpiRes, ws + WS_O, ws + WS_WO, M, D, D, (const bf16_t*)(ws + WS_XB), (bf16_t*)(ws + WS_XB), (float*)(ws + WS_PS2), (const float*)nullptr);
    if constexpr (PH == 7) GEMM_PHASE(EpiGU, ws + WS_XB, ws + WS_WGU, M, NGU, D, (bf16_t*)(ws + WS_HF), (const float*)(ws + WS_PS2));
    if constexpr (PH == 8) GEMM_PHASE(EpiRes, ws + WS_HF, ws + WS_WDN, M, D, DFF, (const bf16_t*)(ws + WS_XB), (bf16_t*)(ws + WS_XB), (float*)(ws + WS_PS3), (const float*)nullptr);
    if constexpr (PH == 9) p9_final(F, F.out);
    if constexpr (PH == 19) p9_final(F, (float*)(ws + WS_H));
}

template <int PH>
__global__ void __launch_bounds__(NTHREADS, 2) phase_kernel(Params p) {
    extern __shared__ __attribute__((aligned(16))) unsigned char lds[];
    Frame F; make_frame(F, p, lds);
    run_phase<PH>(F);
}

__global__ void __launch_bounds__(NTHREADS, 2) mega_kernel(Params p) {
    extern __shared__ __attribute__((aligned(16))) unsigned char lds[];
    Frame F; make_frame(F, p, lds);
    volatile LAS unsigned* MISC = (volatile LAS unsigned*)(F.lds + MISC_OFF);
    if (F.tid < 32) MISC[F.tid] = 0u;
    __syncthreads();
    const XcdBarrier bar = xcd_barrier_post((unsigned*)(p.ws + WS_CTL) + CW_BAR, MISC + 8, F.wave);
#define GRID_BAR() xcd_barrier(bar, F.wave)
#define PROBE2(bit, ph) do { if (MK_PROBE & (1 << (bit))) { run_phase<ph>(F); GRID_BAR(); } } while (0)
    PROBE2(0, 0); run_phase<0>(F); GRID_BAR();
    PROBE2(1, 1); run_phase<1>(F); GRID_BAR();
    PROBE2(2, 2); run_phase<2>(F); GRID_BAR();
    PROBE2(3, 3); run_phase<3>(F); GRID_BAR();
    PROBE2(4, 4); run_phase<4>(F); GRID_BAR();
    PROBE2(5, 5); run_phase<5>(F); GRID_BAR();
    run_phase<6>(F); GRID_BAR();
    PROBE2(7, 7); run_phase<7>(F); GRID_BAR();
    run_phase<8>(F); GRID_BAR();
    PROBE2(9, 19); run_phase<9>(F);
#undef GRID_BAR
}

template <int PH> static void launch_phase(const Params& p, int grid, hipStream_t stream) {
    static bool attr = false;
    if (!attr) { (void)hipFuncSetAttribute((const void*)phase_kernel<PH>, hipFuncAttributeMaxDynamicSharedMemorySize, LDS_BYTES); attr = true; }
    hipLaunchKernelGGL(phase_kernel<PH>, dim3(grid), dim3(NTHREADS), LDS_BYTES, stream, p);
}

extern "C" void kernel_launch(void* const* d_in, const int* in_sizes, int n_in, void* d_out, int out_size, void* d_ws, size_t ws_size, hipStream_t stream) {
    static int grid = 0;
    if (grid == 0) {
        if (n_in != 21 || in_sizes[0] != M * D || out_size != M * D || ws_size < WS_END) { fprintf(stderr, "kernel_launch: unexpected shapes (n_in %d, in0 %d, out %d, ws %zu)\n", n_in, n_in > 0 ? in_sizes[0] : -1, out_size, ws_size); grid = -1; return; }
        int dev = 0, cus = 0, per_cu = 0;
        (void)hipGetDevice(&dev); (void)hipDeviceGetAttribute(&cus, hipDeviceAttributeMultiprocessorCount, dev);
        (void)hipFuncSetAttribute((const void*)mega_kernel, hipFuncAttributeMaxDynamicSharedMemorySize, LDS_BYTES);
        (void)hipOccupancyMaxActiveBlocksPerMultiprocessor(&per_cu, (const void*)mega_kernel, NTHREADS, LDS_BYTES);
        if (per_cu < 1) { fprintf(stderr, "kernel_launch: occupancy query says %d blocks per CU\n", per_cu); per_cu = 1; }
        (void)hipGetLastError();
        grid = cus * 1;
    }
    if (grid < 0) return;
    Params p{};
    for (int i = 0; i < 21; ++i) p.in[i] = (const float*)d_in[i];
    p.out = (float*)d_out; p.ws = (unsigned char*)d_ws; p.ph_lo = 0; p.ph_hi = 10;
    unsigned char* ws = (unsigned char*)d_ws;
#if MK_MODE == 2
    (void)hipMemsetAsync(ws + WS_CTL, 0, CTL_ZERO_BYTES, stream);
    void* args[] = {&p};
    hipError_t e = hipLaunchCooperativeKernel((const void*)mega_kernel, dim3(grid), dim3(NTHREADS), args, LDS_BYTES, stream);
    if (e != hipSuccess) fprintf(stderr, "cooperative launch failed: %s (grid %d)\n", hipGetErrorString(e), grid);
#elif MK_MODE == 1
    launch_phase<0>(p, grid, stream); launch_phase<1>(p, grid, stream); launch_phase<2>(p, grid, stream); launch_phase<3>(p, grid, stream); launch_phase<4>(p, grid, stream);
    launch_phase<5>(p, grid, stream); launch_phase<6>(p, grid, stream); launch_phase<7>(p, grid, stream); launch_phase<8>(p, grid, stream); launch_phase<9>(p, grid, stream);
#else
    launch_phase<0>(p, grid, stream);
    { NEpiAct e{(bf16_t*)(ws + WS_KV), 2 * D, 0}; hipLaunchKernelGGL(gemm_naive<NEpiAct>, dim3(2 * D / 64, MROWS / 64), dim3(256), 0, stream, (const bf16_t*)(ws + WS_MEMN), (const bf16_t*)(ws + WS_WKV), e, D, 0); }
    { NEpiAct e{(bf16_t*)(ws + WS_H), NIN, 1024}; hipLaunchKernelGGL(gemm_naive<NEpiAct>, dim3(NIN / 64, M / 64), dim3(256), 0, stream, (const bf16_t*)(ws + WS_XB), (const bf16_t*)(ws + WS_WIN), e, D, 0); }
    launch_phase<2>(p, grid, stream);
    { NEpiRes e{(const float*)d_in[I_X], (float*)d_out, (bf16_t*)(ws + WS_XB)}; hipLaunchKernelGGL(gemm_naive<NEpiRes>, dim3(D / 64, M / 64), dim3(256), 0, stream, (const bf16_t*)(ws + WS_Y), (const bf16_t*)(ws + WS_WOUT), e, D, 0); }
    hipLaunchKernelGGL(naive_rowsumsq, dim3(M / 4), dim3(256), 0, stream, (const float*)d_out, (float*)(ws + WS_PS1));
    { NEpiRowScale e{(bf16_t*)(ws + WS_Q), (const float*)(ws + WS_PS1), D, QSCALE}; hipLaunchKernelGGL(gemm_naive<NEpiRowScale>, dim3(D / 64, M / 64), dim3(256), 0, stream, (const bf16_t*)(ws + WS_XB), (const bf16_t*)(ws + WS_WQ), e, D, 0); }
    launch_phase<5>(p, grid, stream);
    { NEpiRes e{(const float*)d_out, (float*)d_out, (bf16_t*)(ws + WS_XB)}; hipLaunchKernelGGL(gemm_naive<NEpiRes>, dim3(D / 64, M / 64), dim3(256), 0, stream, (const bf16_t*)(ws + WS_O), (const bf16_t*)(ws + WS_WO), e, D, 0); }
    hipLaunchKernelGGL(naive_rowsumsq, dim3(M / 4), dim3(256), 0, stream, (const float*)d_out, (float*)(ws + WS_PS2));
    hipLaunchKernelGGL(naive_gu, dim3(DFF / 32, M / 64), dim3(256), 0, stream, (const bf16_t*)(ws + WS_XB), (const bf16_t*)(ws + WS_WGU), (const float*)(ws + WS_PS2), (bf16_t*)(ws + WS_HF));
    { NEpiRes e{(const float*)d_out, (float*)d_out, (bf16_t*)nullptr}; hipLaunchKernelGGL(gemm_naive<NEpiRes>, dim3(D / 64, M / 64), dim3(256), 0, stream, (const bf16_t*)(ws + WS_HF), (const bf16_t*)(ws + WS_WDN), e, DFF, 0); }
    hipLaunchKernelGGL(naive_rowsumsq, dim3(M / 4), dim3(256), 0, stream, (const float*)d_out, (float*)(ws + WS_PS3));
    launch_phase<9>(p, grid, stream);
#endif
}
```
